# Optimizing an MI355X kernel written in HIP

```python
import jax, jax.numpy as jnp
from jax import lax
import numpy as np

D_MODEL = 2048
BATCH = 8
SEQ = 2048
DEPTH = 2

N_MEM = 256
HEAD_DIM = 128
FOX_HEADS = 16
DIL_PATTERNS = ((128, 1), (512, 4), (2048, 16))
DIL_GROUP_HEADS = 6
DIL_HEADS = DIL_GROUP_HEADS * len(DIL_PATTERNS)
CROSS_HEADS = 4
D_FF = 5632
NUM_BUCKETS = 32
MAX_DISTANCE = 2048
Q_BLOCK = 128
N_MIXERS = 2
N_FOX_LAYERS = (DEPTH + 1) // 2
N_DIL_LAYERS = DEPTH // 2
RMS_EPS = 1e-6
NEG_INF = -1e30

kernel_name = "hybrid_fox_dilated_macaron"


def rmsnorm(x, g):
    xf = x.astype(jnp.float32)
    y = xf * lax.rsqrt(jnp.mean(xf * xf, axis=-1, keepdims=True) + RMS_EPS)
    return (y * g.astype(jnp.float32)).astype(x.dtype)


def swiglu(h, w_in, w_out):
    gu = h @ w_in
    gate, up = gu[..., :D_FF], gu[..., D_FF:]
    return (jax.nn.silu(gate) * up) @ w_out


def t5_bucket(dist):
    max_exact = NUM_BUCKETS // 2
    d = np.maximum(dist, 1).astype(np.float32)
    large = max_exact + (np.log(d / max_exact) / np.log(MAX_DISTANCE / max_exact)
                         * (NUM_BUCKETS - max_exact)).astype(np.int32)
    large = np.minimum(large, NUM_BUCKETS - 1)
    return np.where(dist < max_exact, dist, large).astype(np.int32)


def fox_mixer(h, w_in, b_f, w_out):
    B, S, _ = h.shape
    HD = FOX_HEADS * HEAD_DIM
    proj = h @ w_in
    q = proj[..., :HD].reshape(B, S, FOX_HEADS, HEAD_DIM)
    k = proj[..., HD:2 * HD].reshape(B, S, FOX_HEADS, HEAD_DIM)
    v = proj[..., 2 * HD:3 * HD].reshape(B, S, FOX_HEADS, HEAD_DIM)
    logf = jax.nn.log_sigmoid((proj[..., 3 * HD:] + b_f).astype(jnp.float32))
    c = jnp.cumsum(logf, axis=1).transpose(0, 2, 1)
    scale = HEAD_DIM ** -0.5
    pos = jnp.arange(S)

    def one_block(i):
        start = i * Q_BLOCK
        qb = lax.dynamic_slice_in_dim(q, start, Q_BLOCK, axis=1)
        cq = lax.dynamic_slice_in_dim(c, start, Q_BLOCK, axis=2)
        t = start + jnp.arange(Q_BLOCK)
        logits = (jnp.einsum('bqhd,bshd->bhqs', qb, k).astype(jnp.float32) * scale
                  + cq[..., None] - c[:, :, None, :])
        causal = pos[None, :] <= t[:, None]
        logits = jnp.where(causal[None, None], logits, NEG_INF)
        p = jax.nn.softmax(logits, axis=-1).astype(v.dtype)
        return jnp.einsum('bhqs,bshd->bqhd', p, v)

    o = lax.map(one_block, jnp.arange(S // Q_BLOCK))
    o = o.transpose(1, 0, 2, 3, 4).reshape(B, S, HD)
    return o @ w_out


def dilated_group_attention(q, k, v, bias_gk, dil, n_keys):
    B, S, G, dh = q.shape
    offs = jnp.asarray(np.arange(n_keys) * dil, jnp.int32)
    scale = dh ** -0.5

    def one_block(i):
        start = i * Q_BLOCK
        t = start + jnp.arange(Q_BLOCK)
        idx = t[:, None] - offs[None, :]
        valid = idx >= 0
        idx = jnp.maximum(idx, 0)
        qb = lax.dynamic_slice_in_dim(q, start, Q_BLOCK, axis=1)
        kb = k[:, idx]
        vb = v[:, idx]
        logits = (jnp.einsum('bqgd,bqkgd->bgqk', qb, kb).astype(jnp.float32) * scale
                  + bias_gk[None, :, None, :])
        logits = jnp.where(valid[None, None], logits, NEG_INF)
        m = jnp.max(logits, axis=-1, keepdims=True)
        e = jnp.exp(logits - m)
        den = jnp.sum(e, axis=-1, keepdims=True)
        p = (e / den).astype(v.dtype)
        out = jnp.einsum('bgqk,bqkgd->bqgd', p, vb)
        lse = (m + jnp.log(den))[..., 0].transpose(0, 2, 1)
        return out, lse

    o, lse = lax.map(one_block, jnp.arange(S // Q_BLOCK))
    o = o.transpose(1, 0, 2, 3, 4).reshape(B, S, G, dh)
    lse = lse.transpose(1, 0, 2, 3).reshape(B, S, G)
    return o, lse


def dilated_mixer(h, w_in, w_out, rel_bias):
    B, S, _ = h.shape
    n_g = len(DIL_PATTERNS)
    HD = DIL_HEADS * HEAD_DIM
    proj = h @ w_in
    q = proj[..., :HD].reshape(B, S, n_g, DIL_GROUP_HEADS, HEAD_DIM)
    k = proj[..., HD:2 * HD].reshape(B, S, n_g, DIL_GROUP_HEADS, HEAD_DIM)
    v = proj[..., 2 * HD:].reshape(B, S, n_g, DIL_GROUP_HEADS, HEAD_DIM)
    outs, lses = [], []
    for g, (window, dil) in enumerate(DIL_PATTERNS):
        n_keys = window // dil + 1
        buckets = t5_bucket(np.arange(n_keys) * dil)
        bias = rel_bias[buckets][:, g * DIL_GROUP_HEADS:(g + 1) * DIL_GROUP_HEADS]
        bias = bias.T.astype(jnp.float32)
        o, lse = dilated_group_attention(q[:, :, g], k[:, :, g], v[:, :, g], bias, dil, n_keys)
        outs.append(o)
        lses.append(lse)
    o = jnp.stack(outs, axis=2)
    alpha = jax.nn.softmax(jnp.stack(lses, axis=2), axis=2)
    mixed = (o * alpha[..., None].astype(o.dtype)).reshape(B, S, HD)
    return mixed @ w_out


def memory_cross_attention(h, mem_n, w_q, w_kv, w_out):
    B, S, _ = h.shape
    M = mem_n.shape[1]
    q = (h @ w_q).reshape(B, S, CROSS_HEADS, HEAD_DIM)
    kv = (mem_n @ w_kv).reshape(B, M, 2, CROSS_HEADS, HEAD_DIM)
    logits = jnp.einsum('bshd,bmhd->bhsm', q, kv[:, :, 0]).astype(jnp.float32) * HEAD_DIM ** -0.5
    p = jax.nn.softmax(logits, axis=-1).astype(kv.dtype)
    o = jnp.einsum('bhsm,bmhd->bshd', p, kv[:, :, 1]).reshape(B, S, CROSS_HEADS * HEAD_DIM)
    return o @ w_out


def setup_inputs(seed: int = 0) -> dict:
    key = jax.random.key(seed)
    ks = jax.random.split(key, 24)
    f32 = jnp.float32

    def nrm(k, shape, scale):
        return jax.random.normal(k, shape, f32) * scale

    def gain(k, shape):
        return 1.0 + 0.02 * jax.random.normal(k, shape, f32)

    D = D_MODEL
    fox_hd = FOX_HEADS * HEAD_DIM
    dil_hd = DIL_HEADS * HEAD_DIM
    cr_hd = CROSS_HEADS * HEAD_DIM
    return {
        "x": jax.random.normal(ks[0], (BATCH, SEQ, D), f32),
        "mem": jax.random.normal(ks[1], (BATCH, N_MEM, D), f32),
        "ffn1_norm": gain(ks[2], (DEPTH, D)),
        "ffn1_w_in": nrm(ks[3], (DEPTH, D, 2 * D_FF), D ** -0.5),
        "ffn1_w_out": nrm(ks[4], (DEPTH, D_FF, D), D_FF ** -0.5),
        "mix_norm": gain(ks[5], (DEPTH, D)),
        "fox_w_in": nrm(ks[6], (N_FOX_LAYERS, D, 3 * fox_hd + FOX_HEADS), D ** -0.5),
        "fox_b_f": 3.0 + 0.5 * jax.random.normal(ks[7], (N_FOX_LAYERS, FOX_HEADS), f32),
        "fox_w_out": nrm(ks[8], (N_FOX_LAYERS, fox_hd, D), fox_hd ** -0.5),
        "dil_w_in": nrm(ks[9], (N_DIL_LAYERS, D, 3 * dil_hd), D ** -0.5),
        "dil_w_out": nrm(ks[10], (N_DIL_LAYERS, dil_hd, D), dil_hd ** -0.5),
        "rel_bias": nrm(ks[11], (NUM_BUCKETS, DIL_HEADS), 0.3),
        "cross_norm": gain(ks[12], (DEPTH, D)),
        "mem_norm": gain(ks[13], (D,)),
        "cross_w_q": nrm(ks[14], (DEPTH, D, cr_hd), D ** -0.5),
        "cross_w_kv": nrm(ks[15], (DEPTH, D, 2 * cr_hd), D ** -0.5),
        "cross_w_out": nrm(ks[16], (DEPTH, cr_hd, D), cr_hd ** -0.5),
        "ffn2_norm": gain(ks[17], (DEPTH, D)),
        "ffn2_w_in": nrm(ks[18], (DEPTH, D, 2 * D_FF), D ** -0.5),
        "ffn2_w_out": nrm(ks[19], (DEPTH, D_FF, D), D_FF ** -0.5),
        "final_norm": gain(ks[20], (D,)),
    }


def reference(x, mem, ffn1_norm, ffn1_w_in, ffn1_w_out, mix_norm, fox_w_in, fox_b_f,
              fox_w_out, dil_w_in, dil_w_out, rel_bias, cross_norm, mem_norm, cross_w_q,
              cross_w_kv, cross_w_out, ffn2_norm, ffn2_w_in, ffn2_w_out, final_norm):
    mem_n = rmsnorm(mem, mem_norm)
    for i in range(DEPTH):
        x = x + 0.5 * swiglu(rmsnorm(x, ffn1_norm[i]), ffn1_w_in[i], ffn1_w_out[i])
        h = rmsnorm(x, mix_norm[i])
        j = i // N_MIXERS
        if i % N_MIXERS == 0:
            x = x + fox_mixer(h, fox_w_in[j], fox_b_f[j], fox_w_out[j])
        else:
            x = x + dilated_mixer(h, dil_w_in[j], dil_w_out[j], rel_bias)
        x = x + memory_cross_attention(rmsnorm(x, cross_norm[i]), mem_n,
                                       cross_w_q[i], cross_w_kv[i], cross_w_out[i])
        x = x + 0.5 * swiglu(rmsnorm(x, ffn2_norm[i]), ffn2_w_in[i], ffn2_w_out[i])
    return rmsnorm(x, final_norm)
```

```cpp
#include <hip/hip_runtime.h>
#include <hip/hip_cooperative_groups.h>
#include <cstdio>
#include <cstdint>
namespace cg = cooperative_groups;

#define LAS __attribute__((address_space(3)))
#define GAS __attribute__((address_space(1)))
typedef unsigned short bf16_t;
typedef short bf16x8 __attribute__((ext_vector_type(8)));
typedef float f32x4 __attribute__((ext_vector_type(4)));
typedef float f32x16 __attribute__((ext_vector_type(16)));
typedef unsigned u32x4 __attribute__((ext_vector_type(4)));
typedef unsigned u32x2 __attribute__((ext_vector_type(2)));

constexpr int BATCH = 8, SEQ = 2048, DM = 2048, TOK = BATCH * SEQ, NMEM = 256, TMEM = BATCH * NMEM;
constexpr int FOXH = 16, DILH = 18, CRH = 4, DFF = 5632;
constexpr int FOX_N = 6160, FOX_QKV = 6144, DIL_N = 6912, DIL_HD = 2304, CR_HD = 512, CR_KV = 1024;
constexpr int ACT_LD = 6912, HB_LD = 2304;
constexpr float LOG2E = 1.4426950408889634f, LN2 = 0.6931471805599453f;
constexpr float QSCALE = 0.08838834764831845f * 1.4426950408889634f;
constexpr float RMS_EPS = 1e-6f;

constexpr size_t MiB = 1u << 20;
constexpr size_t SZ_FFN_IN = 44 * MiB, SZ_FFN_OUT = 22 * MiB;
constexpr size_t WS_FFN_IN = 0;
constexpr size_t WS_FFN_OUT = WS_FFN_IN + 4 * SZ_FFN_IN;
constexpr size_t WS_FOX_IN = WS_FFN_OUT + 4 * SZ_FFN_OUT;
constexpr size_t WS_FOX_OUT = WS_FOX_IN + 25 * MiB;
constexpr size_t WS_DIL_IN = WS_FOX_OUT + 8 * MiB;
constexpr size_t WS_DIL_OUT = WS_DIL_IN + 27 * MiB;
constexpr size_t WS_CQ_W = WS_DIL_OUT + 9 * MiB;
constexpr size_t WS_CKV_W = WS_CQ_W + 4 * MiB;
constexpr size_t WS_CO_W = WS_CKV_W + 8 * MiB;
constexpr size_t WS_MEMN = WS_CO_W + 4 * MiB;
constexpr size_t WS_KV = WS_MEMN + 8 * MiB;
constexpr size_t WS_HB = WS_KV + 8 * MiB;
constexpr size_t WS_ACT = WS_HB + 72 * MiB;
constexpr size_t WS_CQ = WS_ACT + 216 * MiB;
constexpr size_t WS_CO = WS_CQ + 16 * MiB;
constexpr size_t WS_GATE = WS_CO + 16 * MiB;
constexpr size_t WS_LSE = WS_GATE + 1 * MiB;
constexpr size_t WS_XB = WS_LSE + 2 * MiB;
constexpr size_t WS_P = WS_XB + 64 * MiB;
constexpr size_t WS_BAR = WS_P + 2 * MiB;
constexpr size_t WS_END = WS_BAR + 1 * MiB;

constexpr int LDS_BYTES = 149504;

__device__ __forceinline__ unsigned cvt_pk_bf16(float lo, float hi) {
    typedef float f2 __attribute__((ext_vector_type(2))); typedef __bf16 b2 __attribute__((ext_vector_type(2)));
    f2 v = {lo, hi}; b2 b = __builtin_convertvector(v, b2); return __builtin_bit_cast(unsigned, b);
}
__device__ __forceinline__ float bf_lo(unsigned w) { return __uint_as_float(w << 16); }
__device__ __forceinline__ float bf_hi(unsigned w) { return __uint_as_float(w & 0xffff0000u); }
__device__ __forceinline__ float wave_sum(float v) {
#pragma unroll
    for (int o = 1; o < 64; o <<= 1) v += __shfl_xor(v, o);
    return v;
}

namespace pg8 {
constexpr int BM = 256, BK = 64, HALF = 128, HTB = HALF * BK * 2, STAGE_BYTES = 8 * HTB, NXCD = 8, WGM = 8;
__device__ __forceinline__ int lds_byte(int r, int c) { const int st = (r >> 4) * 2 + (c >> 5), rr = r & 15, cc = c & 31, ob = rr * 64 + cc * 2; return st * 1024 + (ob ^ (((ob >> 9) & 1) << 5)); }
__device__ __forceinline__ void stage_rc(int b, int& R, int& C) { const int st = b / 1024, sb = b % 1024, swz = sb ^ (((sb >> 9) & 1) << 5); R = (st >> 1) * 16 + swz / 64; C = (st & 1) * 32 + (swz % 64) / 2; }
__device__ __forceinline__ int perm32(int rho) { const int n = rho >> 4, i = rho & 15; return 8 * (i >> 2) + 4 * n + (i & 3); }

struct Unit { int pm, pn, g; };
struct GemmSet { const bf16_t* A0; const bf16_t* B0; const bf16_t* A1; const bf16_t* B1; int K; int lda; };

struct Order {
    int nM0, nN0, nwg0, nM1, nwg1, G, c;
    __device__ void init(int M0, int N0, int M1, int N1, int G_, int c_) { nM0 = M0 / BM; nN0 = N0 / BM; nwg0 = nM0 * nN0; nM1 = M1 / BM; nwg1 = nM1 * (N1 / BM); G = G_; c = c_; }
    __device__ bool next(int i, Unit& u) const {
        long L = (long)i * G + c;
        if (L < nwg0) {
            int wgid = (int)L; { const int q = nwg0 / NXCD, r = nwg0 % NXCD, xcd = wgid % NXCD, off = wgid / NXCD; wgid = (xcd < r ? xcd * (q + 1) : r * (q + 1) + (xcd - r) * q) + off; }
            const int nig = WGM * nN0, gid = wgid / nig, fm = gid * WGM, gsz = (nM0 - fm) < WGM ? (nM0 - fm) : WGM;
            u.pm = fm + ((wgid % nig) % gsz); u.pn = (wgid % nig) / gsz; u.g = 0; return true;
        }
        L -= nwg0;
        if (L < nwg1) { u.pm = (int)(L % nM1); u.pn = (int)(L / nM1); u.g = 1; return true; }
        return false;
    }
};

__device__ __forceinline__ float silu_f(float x) { return x * __builtin_amdgcn_rcpf(1.0f + __builtin_amdgcn_exp2f(-LOG2E * x)); }

__device__ __forceinline__ void row_rstd(const float* P, int pm, int row0, int fq, int lane, LAS float* cache, int& tag, float (&rs)[2][4]) {
    if (!P) {
#pragma unroll
        for (int ai = 0; ai < 2; ++ai)
#pragma unroll
            for (int m = 0; m < 4; ++m) rs[ai][m] = 1.0f;
        return;
    }
    if (tag != pm) {
        tag = pm;
#pragma unroll
        for (int ai = 0; ai < 2; ++ai)
#pragma unroll
            for (int m = 0; m < 4; ++m) {
                const float* pp = P + (size_t)(row0 + ai * HALF + m * 16) * 32 + fq * 8; const f32x4 a = *(const GAS f32x4*)pp, b = *(const GAS f32x4*)(pp + 4);
                float s = ((a.x + a.y) + (a.z + a.w)) + ((b.x + b.y) + (b.z + b.w)); s += __shfl_xor(s, 16); s += __shfl_xor(s, 32);
                rs[ai][m] = __builtin_amdgcn_rsqf(s * (1.0f / DM) + RMS_EPS);
                cache[(ai * 4 + m) * 64 + lane] = rs[ai][m];
            }
    } else {
#pragma unroll
        for (int ai = 0; ai < 2; ++ai)
#pragma unroll
            for (int m = 0; m < 4; ++m) rs[ai][m] = cache[(ai * 4 + m) * 64 + lane];
    }
}
struct EpiSwiglu {
    static constexpr bool PERM = true;
    bf16_t* O; const float* P;
    __device__ __forceinline__ void operator()(const f32x4 (&acc)[2][2][4][2], const Unit& u, int wr, int wc, int fr, int fq, LAS float* cache, int& tag) const {
        const int row0 = u.pm * BM + wr * 64 + fr, col0 = u.pn * 128 + wc * 32 + 8 * fq;
        float rs[2][4]; row_rstd(P, u.pm, row0, fq, fr + 16 * fq, cache, tag, rs);
#pragma unroll
        for (int ai = 0; ai < 2; ++ai)
#pragma unroll
            for (int m = 0; m < 4; ++m) {
                bf16_t* rowp = O + (size_t)(row0 + ai * HALF + m * 16) * ACT_LD + col0; const float r = rs[ai][m];
                const float nrl = -LOG2E * r, r2 = r * r;
                const f32x4 ga = acc[ai][0][m][0], gb = acc[ai][0][m][1];
                const f32x4 pa = (ga * acc[ai][1][m][0]) * r2, pb = (gb * acc[ai][1][m][1]) * r2;
                const f32x4 ta = ga * nrl, tb = gb * nrl;
                f32x4 da, db;
#pragma unroll
                for (int j = 0; j < 4; ++j) { da[j] = __builtin_amdgcn_exp2f(ta[j]); db[j] = __builtin_amdgcn_exp2f(tb[j]); }
                da = da + 1.0f; db = db + 1.0f;
#pragma unroll
                for (int j = 0; j < 4; ++j) { da[j] = __builtin_amdgcn_rcpf(da[j]); db[j] = __builtin_amdgcn_rcpf(db[j]); }
                const f32x4 oa = pa * da, ob = pb * db;
                u32x4 w; w.x = cvt_pk_bf16(oa[0], oa[1]); w.y = cvt_pk_bf16(oa[2], oa[3]); w.z = cvt_pk_bf16(ob[0], ob[1]); w.w = cvt_pk_bf16(ob[2], ob[3]);
                *(GAS u32x4*)rowp = w;
            }
    }
};
struct EpiResid {
    static constexpr bool PERM = true;
    const float* base32; bf16_t* xb; float* out32; float alpha; float* P;
    __device__ __forceinline__ void operator()(const f32x4 (&acc)[2][2][4][2], const Unit& u, int wr, int wc, int fr, int fq, LAS float* cache, int& tag) const {
        const int row0 = u.pm * BM + wr * 64 + fr, col0 = u.pn * BM + wc * 32 + 8 * fq;
        if (!base32) {
            u32x4 xv[2][4][2];
#pragma unroll
            for (int ai = 0; ai < 2; ++ai)
#pragma unroll
                for (int m = 0; m < 4; ++m)
#pragma unroll
                    for (int bj = 0; bj < 2; ++bj) xv[ai][m][bj] = *(const GAS u32x4*)(xb + (size_t)(row0 + ai * HALF + m * 16) * DM + col0 + bj * HALF);
            asm volatile("" ::: "memory");
#pragma unroll
            for (int ai = 0; ai < 2; ++ai)
#pragma unroll
                for (int m = 0; m < 4; ++m) {
                    const int row = row0 + ai * HALF + m * 16; const size_t off = (size_t)row * DM + col0; float ss = 0.f;
#pragma unroll
                    for (int bj = 0; bj < 2; ++bj) {
                        const u32x4 b = xv[ai][m][bj];
                        f32x4 x0 = (f32x4){bf_lo(b.x), bf_hi(b.x), bf_lo(b.y), bf_hi(b.y)}, x1 = (f32x4){bf_lo(b.z), bf_hi(b.z), bf_lo(b.w), bf_hi(b.w)};
                        x0 = x0 + acc[ai][bj][m][0] * alpha; x1 = x1 + acc[ai][bj][m][1] * alpha;
                        ss += ((x0.x * x0.x + x0.y * x0.y) + (x0.z * x0.z + x0.w * x0.w)) + ((x1.x * x1.x + x1.y * x1.y) + (x1.z * x1.z + x1.w * x1.w));
                        if (out32) { *(GAS f32x4*)(out32 + off + bj * HALF) = x0; *(GAS f32x4*)(out32 + off + bj * HALF + 4) = x1; }
                        else { u32x4 w; w.x = cvt_pk_bf16(x0.x, x0.y); w.y = cvt_pk_bf16(x0.z, x0.w); w.z = cvt_pk_bf16(x1.x, x1.y); w.w = cvt_pk_bf16(x1.z, x1.w); *(GAS u32x4*)(xb + off + bj * HALF) = w; }
                    }
                    ss += __shfl_xor(ss, 16); ss += __shfl_xor(ss, 32); if (fq == 0) ((GAS float*)P)[(size_t)row * 32 + u.pn * 4 + wc] = ss;
                }
            return;
        }
#pragma unroll
        for (int ai = 0; ai < 2; ++ai)
#pragma unroll
            for (int m = 0; m < 4; ++m) {
                const int row = row0 + ai * HALF + m * 16; const size_t off = (size_t)row * DM + col0; float ss = 0.f;
#pragma unroll
                for (int bj = 0; bj < 2; ++bj) {
                    f32x4 x0, x1;
                    if (base32) { x0 = *(const GAS f32x4*)(base32 + off + bj * HALF); x1 = *(const GAS f32x4*)(base32 + off + bj * HALF + 4); }
                    else { const u32x4 b = *(const GAS u32x4*)(xb + off + bj * HALF); x0 = (f32x4){bf_lo(b.x), bf_hi(b.x), bf_lo(b.y), bf_hi(b.y)}; x1 = (f32x4){bf_lo(b.z), bf_hi(b.z), bf_lo(b.w), bf_hi(b.w)}; }
                    x0 = x0 + acc[ai][bj][m][0] * alpha; x1 = x1 + acc[ai][bj][m][1] * alpha;
                    ss += ((x0.x * x0.x + x0.y * x0.y) + (x0.z * x0.z + x0.w * x0.w)) + ((x1.x * x1.x + x1.y * x1.y) + (x1.z * x1.z + x1.w * x1.w));
                    if (out32) { *(GAS f32x4*)(out32 + off + bj * HALF) = x0; *(GAS f32x4*)(out32 + off + bj * HALF + 4) = x1; }
                    else { u32x4 w; w.x = cvt_pk_bf16(x0.x, x0.y); w.y = cvt_pk_bf16(x0.z, x0.w); w.z = cvt_pk_bf16(x1.x, x1.y); w.w = cvt_pk_bf16(x1.z, x1.w); *(GAS u32x4*)(xb + off + bj * HALF) = w; }
                }
                ss += __shfl_xor(ss, 16); ss += __shfl_xor(ss, 32); if (fq == 0) ((GAS float*)P)[(size_t)row * 32 + u.pn * 4 + wc] = ss;
                if (m & 1) asm volatile("" ::: "memory");
            }
    }
};
struct EpiProj {
    static constexpr bool PERM = true;
    bf16_t* O0; int ld0; int nscale; float scale0; int gate_tile; float* gate; bf16_t* O1; int ld1; const float* P;
    __device__ __forceinline__ void operator()(const f32x4 (&acc)[2][2][4][2], const Unit& u, int wr, int wc, int fr, int fq, LAS float* cache, int& tag) const {
        const int row0 = u.pm * BM + wr * 64 + fr;
        float rs[2][4]; row_rstd(u.g ? nullptr : P, u.pm, row0, fq, fr + 16 * fq, cache, tag, rs);
        if (u.g == 0 && u.pn == gate_tile) {
            if (wc == 0 && fq < 2) {
#pragma unroll
                for (int ai = 0; ai < 2; ++ai)
#pragma unroll
                    for (int m = 0; m < 4; ++m) { float* gp = gate + (size_t)(row0 + ai * HALF + m * 16) * 16 + 8 * fq; *(GAS f32x4*)gp = acc[ai][0][m][0] * rs[ai][m]; *(GAS f32x4*)(gp + 4) = acc[ai][0][m][1] * rs[ai][m]; }
            }
            return;
        }
        bf16_t* base = u.g ? O1 : O0; const int ld = u.g ? ld1 : ld0; const float sc = (u.g == 0 && u.pn < nscale) ? scale0 : 1.0f;
        const int col0 = u.pn * BM + wc * 32 + 8 * fq;
#pragma unroll
        for (int ai = 0; ai < 2; ++ai)
#pragma unroll
            for (int m = 0; m < 4; ++m) {
                bf16_t* rowp = base + (size_t)(row0 + ai * HALF + m * 16) * ld + col0; const float r = sc * rs[ai][m];
#pragma unroll
                for (int bj = 0; bj < 2; ++bj) { const f32x4 v0 = acc[ai][bj][m][0] * r, v1 = acc[ai][bj][m][1] * r; u32x4 w; w.x = cvt_pk_bf16(v0[0], v0[1]); w.y = cvt_pk_bf16(v0[2], v0[3]); w.z = cvt_pk_bf16(v1[0], v1[1]); w.w = cvt_pk_bf16(v1[2], v1[3]);
                    *(GAS u32x4*)(rowp + bj * HALF) = w; }
            }
    }
};

template <class Epi>
__device__ __forceinline__ void gemm_phase(LAS unsigned char* lds, const GemmSet g, const Order& S, const Epi& E) {
    int tid = threadIdx.x; asm volatile("" : "+v"(tid));
    const int wid = __builtin_amdgcn_readfirstlane(tid >> 6), lane = tid & 63, wr = wid >> 2, wc = wid & 3, fr = lane & 15, fq = lane >> 4;
    const int K = g.K, nt = K / BK;
    unsigned voffA[2], voffB[2];
#pragma unroll
    for (int i = 0; i < 2; ++i) { int R, C; stage_rc(tid * 16 + i * 8192, R, C); const int Rb = Epi::PERM ? ((R & ~31) + perm32(R & 31)) : R;
        voffA[i] = (unsigned)(R * g.lda + C) * 2u; voffB[i] = (unsigned)(Rb * K + C) * 2u; }
    const size_t kstep = (size_t)(BK * 2);
    const size_t hstep = (size_t)HALF * K * 2;
    const size_t tstep = 2 * hstep;
    const size_t hstepA = (size_t)HALF * g.lda * 2, tstepA = 2 * hstepA;
    const unsigned ldsw = (unsigned)wid * 1024u;
    const int aoff = lds_byte(wr * 64 + fr, fq * 8), boff = lds_byte(wc * 32 + fr, fq * 8);
#define PG8_SA(b, h) (((b) * 2 + (h)) * HTB)
#define PG8_SB(b, h) ((4 + (b) * 2 + (h)) * HTB)
#define PG8_STAGE(bufoff, gbase, voff) do { _Pragma("unroll") for (int _i = 0; _i < 2; ++_i) \
        __builtin_amdgcn_global_load_lds((const unsigned*)((const char*)(gbase) + (voff)[_i]), (LAS unsigned*)(lds + (bufoff) + ldsw + _i * 8192), 16, 0, 0); } while (0)
#define PG8_LDA(dst, b, h) do { _Pragma("unroll") for (int m = 0; m < 4; ++m) _Pragma("unroll") for (int k = 0; k < 2; ++k) dst[m][k] = *(const LAS bf16x8*)(lds + PG8_SA(b, h) + aoff + m * 2048 + k * 1024); } while (0)
#define PG8_LDB(dst, b, h) do { _Pragma("unroll") for (int n = 0; n < 2; ++n) _Pragma("unroll") for (int k = 0; k < 2; ++k) dst[n][k] = *(const LAS bf16x8*)(lds + PG8_SB(b, h) + boff + n * 2048 + k * 1024); } while (0)
#define PG8_MMA(ai, bj, At, Bt) do { __builtin_amdgcn_s_setprio(1); _Pragma("unroll") for (int m = 0; m < 4; ++m) _Pragma("unroll") for (int n = 0; n < 2; ++n) _Pragma("unroll") for (int k = 0; k < 2; ++k) \
        acc[ai][bj][m][n] = __builtin_amdgcn_mfma_f32_16x16x32_bf16(Bt[n][k], At[m][k], acc[ai][bj][m][n], 0, 0, 0); __builtin_amdgcn_s_setprio(0); } while (0)
#define PG8_WAIT_V(n) asm volatile("s_waitcnt vmcnt(" #n ")" ::: "memory")
#define PG8_WAIT_L(n) asm volatile("s_waitcnt lgkmcnt(" #n ")" ::: "memory")
#define PG8_BAR __builtin_amdgcn_s_barrier()
#define PG8_SCHED __builtin_amdgcn_sched_barrier(0)
    Unit cur, nxt; int ui = 0;
    if (!S.next(0, cur)) return;
    LAS float* rcache = (LAS float*)(lds + STAGE_BYTES + 1024 + wid * 2048); int rtag = -1;
    f32x4 acc[2][2][4][2];
#pragma unroll
    for (int a = 0; a < 2; ++a)
#pragma unroll
        for (int b = 0; b < 2; ++b)
#pragma unroll
            for (int m = 0; m < 4; ++m)
#pragma unroll
                for (int n = 0; n < 2; ++n) acc[a][b][m][n] = (f32x4){0.f, 0.f, 0.f, 0.f};
    bf16x8 At[4][2], B0[2][2], B1[2][2];
    const char* cA = (const char*)(cur.g ? g.A1 : g.A0) + (size_t)cur.pm * tstepA; const char* cB = (const char*)(cur.g ? g.B1 : g.B0) + (size_t)cur.pn * tstep;
    PG8_STAGE(PG8_SB(0, 0), cB, voffB); PG8_STAGE(PG8_SB(0, 1), cB + hstep, voffB); PG8_STAGE(PG8_SA(0, 0), cA, voffA); PG8_STAGE(PG8_SA(0, 1), cA + hstepA, voffA);
    if (wr == 1) PG8_BAR;
    PG8_WAIT_V(2); PG8_BAR;
    PG8_STAGE(PG8_SB(1, 0), cB + kstep, voffB); PG8_STAGE(PG8_SA(1, 0), cA + kstep, voffA); PG8_STAGE(PG8_SB(1, 1), cB + hstep + kstep, voffB);
    PG8_WAIT_V(6); PG8_BAR;
    for (;;) {
        const bool has_next = S.next(ui + 1, nxt);
        const char* nA = has_next ? (const char*)(nxt.g ? g.A1 : g.A0) + (size_t)nxt.pm * tstepA : cA; const char* nB = has_next ? (const char*)(nxt.g ? g.B1 : g.B0) + (size_t)nxt.pn * tstep : cB;
        for (int t = 0; t < nt; t += 2) {
            const bool last = (t == nt - 2);
            const char* a1 = cA + (size_t)(t + 1) * kstep;
            const char* a2 = last ? nA : cA + (size_t)(t + 2) * kstep; const char* b2 = last ? nB : cB + (size_t)(t + 2) * kstep;
            const char* a3 = a2 + kstep; const char* b3 = b2 + kstep;
            PG8_LDB(B0, 0, 0); PG8_LDB(B1, 0, 1); PG8_SCHED; PG8_LDA(At, 0, 0); PG8_STAGE(PG8_SA(1, 1), a1 + hstepA, voffA);
            PG8_WAIT_V(8); PG8_WAIT_L(0); PG8_BAR; PG8_MMA(0, 0, At, B0); PG8_MMA(0, 1, At, B1); PG8_BAR; PG8_SCHED;
            PG8_LDA(At, 0, 1); PG8_STAGE(PG8_SB(0, 0), b2, voffB); PG8_STAGE(PG8_SB(0, 1), b2 + hstep, voffB); PG8_STAGE(PG8_SA(0, 0), a2, voffA);
            PG8_WAIT_V(8); PG8_WAIT_L(0); PG8_BAR; PG8_MMA(1, 0, At, B0); PG8_MMA(1, 1, At, B1); PG8_BAR; PG8_SCHED;
            PG8_LDB(B0, 1, 0); PG8_LDB(B1, 1, 1); PG8_SCHED; PG8_LDA(At, 1, 0); PG8_STAGE(PG8_SA(0, 1), a2 + hstepA, voffA);
            PG8_WAIT_V(8); PG8_WAIT_L(0); PG8_BAR; PG8_MMA(0, 0, At, B0); PG8_MMA(0, 1, At, B1); PG8_BAR; PG8_SCHED;
            PG8_LDA(At, 1, 1); PG8_STAGE(PG8_SB(1, 0), b3, voffB); PG8_STAGE(PG8_SB(1, 1), b3 + hstep, voffB); PG8_STAGE(PG8_SA(1, 0), a3, voffA);
            PG8_WAIT_V(8); PG8_WAIT_L(0); PG8_BAR; PG8_MMA(1, 0, At, B0); PG8_MMA(1, 1, At, B1); PG8_BAR; PG8_SCHED;
        }
        if (wr == 0) PG8_BAR;
        E(acc, cur, wr, wc, fr, fq, rcache, rtag);
        if (!has_next) break;
#pragma unroll
        for (int a = 0; a < 2; ++a)
#pragma unroll
            for (int b = 0; b < 2; ++b)
#pragma unroll
                for (int m = 0; m < 4; ++m)
#pragma unroll
                    for (int n = 0; n < 2; ++n) acc[a][b][m][n] = (f32x4){0.f, 0.f, 0.f, 0.f};
        cur = nxt; cA = nA; cB = nB; ++ui;
        if (wr == 1) PG8_BAR;
    }
    PG8_WAIT_V(0);
    PG8_BAR;
#undef PG8_SA
#undef PG8_SB
#undef PG8_STAGE
#undef PG8_LDA
#undef PG8_LDB
#undef PG8_MMA
#undef PG8_WAIT_V
#undef PG8_WAIT_L
#undef PG8_BAR
#undef PG8_SCHED
}
}

namespace att {
constexpr int KROW = 272, VROW = 144, KBUF = 64 * KROW, VBUF = 128 * VROW;
constexpr int OFF_K = 0, OFF_V = 2 * KBUF, OFF_BIAS = OFF_V + 2 * VBUF, OFF_RED = OFF_BIAS + 8192;
struct Args {
    const bf16_t* Q; const bf16_t* K; const bf16_t* V; bf16_t* O; float* lse;
    int q_pitch, kv_pitch, o_pitch, lse_pitch;
    int q_tok0, k_tok0, dil, logL;
    int q0, kt_lo, kt_hi;
    const float* aux; float bf;
};
__device__ __forceinline__ int crow(int r, int hi) { return (r & 3) + 8 * (r >> 2) + 4 * hi; }

template <int MODE>
__device__ __forceinline__ void unit(LAS unsigned char* lds, const Args& a) {
    int tid = threadIdx.x; asm volatile("" : "+v"(tid));
    const int lane = tid & 63, wid = __builtin_amdgcn_readfirstlane(tid >> 6), r32 = lane & 31, hi = lane >> 5;
    const int Lm1 = (1 << a.logL) - 1;
#define ATOK(base, p) ((base) + ((p) >> a.logL) + ((p) & Lm1) * a.dil)
    LAS float* bl = (LAS float*)(lds + OFF_BIAS);
    if (MODE == 1) {
        LAS float* red = (LAS float*)(lds + OFF_RED);
        const float* gz = a.aux + (size_t)a.k_tok0 * 16;
        float v[4];
#pragma unroll
        for (int e = 0; e < 4; ++e) { const float y = ((const GAS float*)gz)[(size_t)(4 * tid + e) * 16] + a.bf; v[e] = fminf(y, 0.f) - log1pf(expf(-fabsf(y))); }
        v[1] += v[0]; v[2] += v[1]; v[3] += v[2];
        const float tot = v[3]; float sc = tot;
#pragma unroll
        for (int o = 1; o < 64; o <<= 1) { const float n = __shfl_up(sc, o); if (lane >= o) sc += n; }
        if (lane == 63) red[wid] = sc;
        __syncthreads();
        float woff = 0.f;
        for (int w = 0; w < wid; ++w) woff += red[w];
        const float excl = woff + sc - tot;
#pragma unroll
        for (int e = 0; e < 4; ++e) bl[4 * tid + e] = -(excl + v[e]) * LOG2E;
    } else if (MODE == 2) {
        if (tid < 320) bl[tid] = -1e30f;
        __syncthreads();
        if (tid <= 128) {
            const int d = tid * a.dil; int bucket;
            if (d < 16) bucket = d;
            else {
                bucket = 16 + (d >= 22) + (d >= 30) + (d >= 40) + (d >= 54) + (d >= 73) + (d >= 99) + (d >= 134) + (d >= 182) + (d >= 246) + (d >= 332) + (d >= 450) + (d >= 609) + (d >= 825) + (d >= 1117) + (d >= 1513);
            }
            bl[96 + tid] = ((const GAS float*)a.aux)[bucket * DILH] * LOG2E;
        }
    }
    const int qlo = a.q0 + 32 * wid, qp = qlo + r32;
    const size_t qtok = (size_t)ATOK(a.q_tok0, qp);
    bf16x8 qf[8];
    { const bf16_t* qrow = a.Q + qtok * a.q_pitch + 8 * hi;
#pragma unroll
      for (int ks = 0; ks < 8; ++ks) qf[ks] = *(const GAS bf16x8*)(qrow + 16 * ks); }
    f32x16 o[4];
#pragma unroll
    for (int db = 0; db < 4; ++db)
#pragma unroll
        for (int r = 0; r < 16; ++r) o[db][r] = 0.f;
    float mrun = -1e29f, lrun = 0.f;
    u32x4 kreg[2], vreg[2];
#define LOAD_TILE(kt) do { _Pragma("unroll") for (int i_ = 0; i_ < 2; ++i_) { const int id_ = tid + 512 * i_; \
        { const int row_ = id_ >> 4, ch_ = id_ & 15, kp_ = 64 * (kt) + row_; kreg[i_] = *(const GAS u32x4*)(a.K + (size_t)ATOK(a.k_tok0, kp_) * a.kv_pitch + ch_ * 8); } \
        { const int kv_ = id_ & 63, ch_ = id_ >> 6, kp_ = 64 * (kt) + kv_; vreg[i_] = *(const GAS u32x4*)(a.V + (size_t)ATOK(a.k_tok0, kp_) * a.kv_pitch + ch_ * 8); } } } while (0)
#define STORE_TILE(buf) do { _Pragma("unroll") for (int i_ = 0; i_ < 2; ++i_) { const int id_ = tid + 512 * i_; \
        { const int row_ = id_ >> 4, ch_ = id_ & 15; *(LAS u32x4*)(lds + OFF_K + (buf) * KBUF + row_ * KROW + ch_ * 16) = kreg[i_]; } \
        { const int kv_ = id_ & 63, ch_ = id_ >> 6; const int pos_ = (kv_ & ~15) | (kv_ & 3) | ((kv_ & 4) << 1) | ((kv_ & 8) >> 1); \
          LAS unsigned short* vp_ = (LAS unsigned short*)(lds + OFF_V + (buf) * VBUF + (8 * ch_) * VROW + pos_ * 2); \
          _Pragma("unroll") for (int e_ = 0; e_ < 8; ++e_) vp_[e_ * (VROW / 2)] = (unsigned short)(vreg[i_][e_ >> 1] >> (16 * (e_ & 1))); } } } while (0)
    constexpr bool REV = (MODE == 1);
    const int ntile = a.kt_hi - a.kt_lo;
    LOAD_TILE(REV ? a.kt_hi - 1 : a.kt_lo); STORE_TILE(0);
    __syncthreads();
    for (int it = 0; it < ntile; ++it) {
        const int kt = REV ? a.kt_hi - 1 - it : a.kt_lo + it;
        const int buf = it & 1;
        const bool more = it + 1 < ntile;
        if (more) LOAD_TILE(REV ? kt - 1 : kt + 1);
        const int klo = 64 * kt;
        bool skip = false, need_mask = false;
        if (MODE == 1) { skip = klo > qlo + 31; need_mask = klo + 63 > qlo; }
        if (MODE == 2) { skip = (klo > qlo + 31) || (klo + 63 < qlo - 128) || ((klo >> a.logL) != (qlo >> a.logL)); need_mask = true; }
        if (!skip) {
            f32x16 s0, s1;
#pragma unroll
            for (int r = 0; r < 16; ++r) { s0[r] = 0.f; s1[r] = 0.f; }
            const LAS unsigned char* kb = lds + OFF_K + buf * KBUF + r32 * KROW + hi * 16;
#pragma unroll
            for (int ks = 0; ks < 8; ++ks) {
                const bf16x8 a0 = *(const LAS bf16x8*)(kb + ks * 32); const bf16x8 a1 = *(const LAS bf16x8*)(kb + 32 * KROW + ks * 32);
                s0 = __builtin_amdgcn_mfma_f32_32x32x16_bf16(a0, qf[ks], s0, 0, 0, 0); s1 = __builtin_amdgcn_mfma_f32_32x32x16_bf16(a1, qf[ks], s1, 0, 0, 0);
            }
            if (MODE == 1) {
#pragma unroll
                for (int g4 = 0; g4 < 4; ++g4) { const f32x4 b0 = *(const LAS f32x4*)(bl + klo + 8 * g4 + 4 * hi), b1 = *(const LAS f32x4*)(bl + klo + 32 + 8 * g4 + 4 * hi);
#pragma unroll
                    for (int j = 0; j < 4; ++j) { s0[4 * g4 + j] += b0[j]; s1[4 * g4 + j] += b1[j]; } }
                if (need_mask) {
#pragma unroll
                    for (int r = 0; r < 16; ++r) { const int kp0 = klo + crow(r, hi); if (kp0 > qp) s0[r] = -1e30f; if (kp0 + 32 > qp) s1[r] = -1e30f; }
                }
            }
            if (MODE == 2) {
                const LAS float* tb = bl + (qp - klo - 4 * hi + 96 - 59);
#pragma unroll
                for (int r = 0; r < 16; ++r) { const int c = (r & 3) + 8 * (r >> 2); s0[r] += tb[59 - c]; s1[r] += tb[59 - c - 32]; }
            }
#define MX3(a_, b_, c_) __builtin_fmaxf(__builtin_fmaxf((a_), (b_)), (c_))
            float ma = MX3(s0[0], s0[1], s1[0]), mb = MX3(s0[2], s0[3], s1[1]); ma = MX3(ma, s1[2], s1[3]);
#pragma unroll
            for (int r = 4; r < 16; r += 4) { ma = MX3(ma, s0[r], s0[r + 1]); mb = MX3(mb, s0[r + 2], s0[r + 3]); ma = MX3(ma, s1[r], s1[r + 1]); mb = MX3(mb, s1[r + 2], s1[r + 3]); }
#undef MX3
            float rm = fmaxf(ma, mb);
            rm = fmaxf(rm, __shfl_xor(rm, 32));
            const float mn = fmaxf(mrun, rm); const float alpha = __builtin_amdgcn_exp2f(mrun - mn); mrun = mn;
            float ps = 0.f;
#pragma unroll
            for (int r = 0; r < 16; ++r) { s0[r] = __builtin_amdgcn_exp2f(s0[r] - mn); s1[r] = __builtin_amdgcn_exp2f(s1[r] - mn); ps += s0[r] + s1[r]; }
            lrun = lrun * alpha + ps;
            if (__any(alpha != 1.0f)) {
#pragma unroll
                for (int db = 0; db < 4; ++db)
#pragma unroll
                    for (int r = 0; r < 16; ++r) o[db][r] *= alpha;
            }
            bf16x8 pj[4];
#pragma unroll
            for (int jj = 0; jj < 2; ++jj) {
                u32x4 w0, w1;
                w0.x = cvt_pk_bf16(s0[8 * jj + 0], s0[8 * jj + 1]); w0.y = cvt_pk_bf16(s0[8 * jj + 2], s0[8 * jj + 3]); w0.z = cvt_pk_bf16(s0[8 * jj + 4], s0[8 * jj + 5]); w0.w = cvt_pk_bf16(s0[8 * jj + 6], s0[8 * jj + 7]);
                w1.x = cvt_pk_bf16(s1[8 * jj + 0], s1[8 * jj + 1]); w1.y = cvt_pk_bf16(s1[8 * jj + 2], s1[8 * jj + 3]); w1.z = cvt_pk_bf16(s1[8 * jj + 4], s1[8 * jj + 5]); w1.w = cvt_pk_bf16(s1[8 * jj + 6], s1[8 * jj + 7]);
                pj[jj] = __builtin_bit_cast(bf16x8, w0); pj[2 + jj] = __builtin_bit_cast(bf16x8, w1);
            }
            const LAS unsigned char* vb = lds + OFF_V + buf * VBUF + r32 * VROW + hi * 16;
#pragma unroll
            for (int db = 0; db < 4; ++db)
#pragma unroll
                for (int j = 0; j < 4; ++j) { const bf16x8 va = *(const LAS bf16x8*)(vb + db * 32 * VROW + j * 32); o[db] = __builtin_amdgcn_mfma_f32_32x32x16_bf16(va, pj[j], o[db], 0, 0, 0); }
        }
        if (more) STORE_TILE(buf ^ 1);
        __syncthreads();
    }
    lrun += __shfl_xor(lrun, 32);
    const float inv = 1.0f / lrun;
    bf16_t* orow = a.O + qtok * a.o_pitch;
#pragma unroll
    for (int db = 0; db < 4; ++db)
#pragma unroll
        for (int g4 = 0; g4 < 4; ++g4) { u32x2 w; w.x = cvt_pk_bf16(o[db][4 * g4] * inv, o[db][4 * g4 + 1] * inv); w.y = cvt_pk_bf16(o[db][4 * g4 + 2] * inv, o[db][4 * g4 + 3] * inv);
            *(GAS u32x2*)(orow + 32 * db + 8 * g4 + 4 * hi) = w; }
    if (MODE == 2) { if (hi == 0) ((GAS float*)a.lse)[qtok * a.lse_pitch] = (mrun + log2f(lrun)) * LN2; }
#undef LOAD_TILE
#undef STORE_TILE
#undef ATOK
}
}


__device__ __forceinline__ unsigned xb_xcc_id() { return (unsigned)__builtin_amdgcn_s_getreg((3 << 11) | 20) & 0xFu; }
__device__ __forceinline__ void group_barrier(unsigned* cnt, unsigned n, int wb) {
    asm volatile("s_waitcnt vmcnt(0)" ::: "memory");
    __syncthreads();
    if (threadIdx.x == 0) {
        if (wb) { __builtin_amdgcn_fence(__ATOMIC_RELEASE, "agent"); asm volatile("s_waitcnt vmcnt(0)" ::: "memory"); }
        const unsigned old = __hip_atomic_fetch_add(cnt, 1u, __ATOMIC_RELAXED, __HIP_MEMORY_SCOPE_AGENT);
        const unsigned target = (old / n + 1u) * n;
        unsigned sp = 0u;
        while (__hip_atomic_load(cnt, __ATOMIC_RELAXED, __HIP_MEMORY_SCOPE_AGENT) < target) { __builtin_amdgcn_s_sleep(1); if (++sp > (1u << 26)) break; }
        __builtin_amdgcn_fence(__ATOMIC_ACQUIRE, "agent");
        asm volatile("s_waitcnt vmcnt(0)" ::: "memory");
    }
    __syncthreads();
}
struct Topo {
    unsigned* xcnt; unsigned* pcnt; unsigned nx, np; int wb, fast;
    int b0, NB, nloc, k;
    int pm, member;
};

__device__ __forceinline__ int dest_row(int kind, int n) { if (kind == 0) return n; const int half = n >= DFF ? 1 : 0, c = n - half * DFF; return 256 * (c >> 7) + 128 * half + (c & 127); }
__device__ __forceinline__ void transpose_item(const float* W, int K, int N, bf16_t* WT, int kind, const float* gfold, LAS float* scr, int item, int lane) {
    const int nblk = (N + 31) / 32, kb = item / nblk, nb = item % nblk, k0 = 64 * kb, n0 = 32 * nb;
    const int nn = n0 + 4 * (lane & 7); const bool ok = nn < N;
    f32x4 v[8];
#pragma unroll
    for (int i = 0; i < 8; ++i) { const int kk = 8 * i + (lane >> 3); v[i] = ok ? __builtin_nontemporal_load((const GAS f32x4*)(W + (size_t)(k0 + kk) * N + nn)) : (f32x4){0.f, 0.f, 0.f, 0.f}; }
    if (gfold) {
#pragma unroll
        for (int i = 0; i < 8; ++i) v[i] = v[i] * ((const GAS float*)gfold)[k0 + 8 * i + (lane >> 3)];
    }
#pragma unroll
    for (int i = 0; i < 8; ++i) { LAS float* d = scr + (8 * i + (lane >> 3)) * 33 + 4 * (lane & 7); d[0] = v[i].x; d[1] = v[i].y; d[2] = v[i].z; d[3] = v[i].w; }
    asm volatile("s_waitcnt lgkmcnt(0)" ::: "memory");
    const int c = lane & 7;
#pragma unroll
    for (int j = 0; j < 4; ++j) { const int n = (lane >> 3) + 8 * j; const LAS float* s = scr + (8 * c) * 33 + n;
        u32x4 o; o.x = cvt_pk_bf16(s[0 * 33], s[1 * 33]); o.y = cvt_pk_bf16(s[2 * 33], s[3 * 33]); o.z = cvt_pk_bf16(s[4 * 33], s[5 * 33]); o.w = cvt_pk_bf16(s[6 * 33], s[7 * 33]);
        *(GAS u32x4*)(WT + (size_t)dest_row(kind, n0 + n) * K + k0 + 8 * c) = o; }
    asm volatile("s_waitcnt lgkmcnt(0)" ::: "memory");
}
__device__ __forceinline__ void convert_matrix(const float* W, int K, int N, bf16_t* WT, int kind, const float* gfold, LAS float* scr, int gw, int ngw, int lane) {
    asm volatile("" : "+v"(lane));
    const int nitems = (K / 64) * ((N + 31) / 32);
    for (int it = gw; it < nitems; it += ngw) transpose_item(W, K, N, WT, kind, gfold, scr, it, lane);
}
__device__ __forceinline__ void gate_mini(const bf16_t* xb, const float* P, const bf16_t* Wg, float* gate, int row0, int tid) {
    asm volatile("" : "+v"(tid));
    const int lane = tid & 63, wid = __builtin_amdgcn_readfirstlane(tid >> 6);
    if (wid >= 4) return;
    const int r = lane & 15, kq = lane >> 4, row = row0 + 16 * wid + r;
    const bf16_t* ap = xb + (size_t)row * DM + 8 * kq;
    const bf16_t* bp = Wg + (size_t)r * DM + 8 * kq;
    f32x4 acc = {0.f, 0.f, 0.f, 0.f};
#pragma unroll 8
    for (int kk = 0; kk < 64; ++kk) {
        const bf16x8 a = *(const GAS bf16x8*)(ap + 32 * kk), b = *(const GAS bf16x8*)(bp + 32 * kk);
        acc = __builtin_amdgcn_mfma_f32_16x16x32_bf16(a, b, acc, 0, 0, 0);
    }
    const float* pp = P + (size_t)row * 32 + 8 * kq;
    const f32x4 p0 = *(const GAS f32x4*)pp, p1 = *(const GAS f32x4*)(pp + 4);
    float s = ((p0.x + p0.y) + (p0.z + p0.w)) + ((p1.x + p1.y) + (p1.z + p1.w)); s += __shfl_xor(s, 16); s += __shfl_xor(s, 32);
    const float rs = __builtin_amdgcn_rsqf(s * (1.0f / DM) + RMS_EPS);
#pragma unroll
    for (int j = 0; j < 4; ++j) { const float rr = __shfl(rs, 4 * kq + j); ((GAS float*)gate)[(size_t)(row0 + 16 * wid + 4 * kq + j) * 16 + r] = acc[j] * rr; }
}
__device__ __forceinline__ void rows_to_xb(const float* x, bf16_t* xb, float* P, int nrows, int gw, int ngw, int lane) {
    asm volatile("" : "+v"(lane));
    for (int m = gw; m < nrows; m += ngw) {
        const float* xr = x + (size_t)m * DM + 4 * lane; f32x4 v[8]; float s = 0.f;
#pragma unroll
        for (int j = 0; j < 8; ++j) { v[j] = *(const GAS f32x4*)(xr + 256 * j); s += (v[j].x * v[j].x + v[j].y * v[j].y) + (v[j].z * v[j].z + v[j].w * v[j].w); }
        s = wave_sum(s);
        bf16_t* orow = xb + (size_t)m * DM + 4 * lane;
#pragma unroll
        for (int j = 0; j < 8; ++j) { u32x2 w; w.x = cvt_pk_bf16(v[j].x, v[j].y); w.y = cvt_pk_bf16(v[j].z, v[j].w); *(GAS u32x2*)(orow + 256 * j) = w; }
        if (lane < 32) ((GAS float*)P)[(size_t)m * 32 + lane] = lane == 0 ? s : 0.f;
    }
}
__device__ __forceinline__ void rms_rows_bf16(const float* x, const float* g, bf16_t* out, int out_pitch, int nrows, int gw, int ngw, int lane) {
    asm volatile("" : "+v"(lane));
    f32x4 gg[8];
#pragma unroll
    for (int j = 0; j < 8; ++j) gg[j] = *(const GAS f32x4*)(g + 4 * lane + 256 * j);
    for (int m = gw; m < nrows; m += ngw) {
        const float* xr = x + (size_t)m * DM + 4 * lane; f32x4 v[8]; float s = 0.f;
#pragma unroll
        for (int j = 0; j < 8; ++j) { v[j] = *(const GAS f32x4*)(xr + 256 * j); s += (v[j].x * v[j].x + v[j].y * v[j].y) + (v[j].z * v[j].z + v[j].w * v[j].w); }
        const float rstd = 1.0f / sqrtf(wave_sum(s) * (1.0f / DM) + RMS_EPS);
        bf16_t* orow = out + (size_t)m * out_pitch + 4 * lane;
#pragma unroll
        for (int j = 0; j < 8; ++j) { u32x2 w; w.x = cvt_pk_bf16(v[j].x * rstd * gg[j].x, v[j].y * rstd * gg[j].y); w.y = cvt_pk_bf16(v[j].z * rstd * gg[j].z, v[j].w * rstd * gg[j].w); *(GAS u32x2*)(orow + 256 * j) = w; }
    }
}
__device__ __forceinline__ void rms_rows_f32_inplace(float* x, const float* g, int nrows, int gw, int ngw, int lane) {
    asm volatile("" : "+v"(lane));
    f32x4 gg[8];
#pragma unroll
    for (int j = 0; j < 8; ++j) gg[j] = *(const GAS f32x4*)(g + 4 * lane + 256 * j);
    for (int m = gw; m < nrows; m += ngw) {
        float* xr = x + (size_t)m * DM + 4 * lane; f32x4 v[8]; float s = 0.f;
#pragma unroll
        for (int j = 0; j < 8; ++j) { v[j] = *(const GAS f32x4*)(xr + 256 * j); s += (v[j].x * v[j].x + v[j].y * v[j].y) + (v[j].z * v[j].z + v[j].w * v[j].w); }
        const float rstd = 1.0f / sqrtf(wave_sum(s) * (1.0f / DM) + RMS_EPS);
#pragma unroll
        for (int j = 0; j < 8; ++j) *(GAS f32x4*)(xr + 256 * j) = v[j] * rstd * gg[j];
    }
}

struct KArgs { const float* in[21]; float* out; unsigned char* ws; };
#define PHASE_BEGIN { unsigned char* ws = args.ws; asm volatile("" : "+s"(ws)); float* xr = args.out; asm volatile("" : "+s"(xr)); \
    bf16_t* HB = (bf16_t*)(ws + WS_HB); bf16_t* ACT = (bf16_t*)(ws + WS_ACT); bf16_t* CQ = (bf16_t*)(ws + WS_CQ); bf16_t* CO = (bf16_t*)(ws + WS_CO); \
    bf16_t* MEMN = (bf16_t*)(ws + WS_MEMN); bf16_t* KVB = (bf16_t*)(ws + WS_KV); float* GATE = (float*)(ws + WS_GATE); float* LSE = (float*)(ws + WS_LSE); bf16_t* XB = (bf16_t*)(ws + WS_XB); float* PP = (float*)(ws + WS_P); \
    (void)XB; (void)PP; (void)HB; (void)ACT; (void)CQ; (void)CO; (void)MEMN; (void)KVB; (void)GATE; (void)LSE; (void)xr;
#define SEAM_P      group_barrier(T.pcnt, T.np, T.wb); }
#define SEAM_X      group_barrier(T.xcnt, T.nx, T.wb); }
#define PHASE_END_LAST }

#define PH_PARAMS const KArgs& args, LAS unsigned char* lds, const Topo& T, const int G, const int bx, const int gw, const int ngw, const int lane, const int tid
#define PH_ARGS args, lds, T, G, bx, gw, ngw, lane, tid

template <int layer> __device__ __forceinline__ void mixer_phases(PH_PARAMS) {
                PHASE_BEGIN
                {
                    pg8::GemmSet g; g.A0 = XB; g.B0 = (const bf16_t*)(ws + (layer == 0 ? WS_FOX_IN : WS_DIL_IN)); g.A1 = MEMN; g.B1 = (const bf16_t*)(ws + WS_CKV_W + (size_t)layer * 4 * MiB); g.K = DM; g.lda = DM;
                    if (layer == 0) {
                        const bf16_t* Wg = (const bf16_t*)(ws + WS_FOX_IN) + (size_t)FOX_QKV * DM;
                        if (T.fast) gate_mini(XB, PP, Wg, GATE, 256 * T.pm + 64 * T.member, tid);
                        else for (int blk = bx; blk < TOK / 64; blk += G) gate_mini(XB, PP, Wg, GATE, 64 * blk, tid);
                    }
                    pg8::Order S; if (layer == 0) S.init(TOK, FOX_QKV, 0, 0, G, bx); else S.init(TOK, DIL_N, TMEM, CR_KV, G, bx);
                    pg8::EpiProj E; E.O0 = ACT; E.ld0 = ACT_LD; E.nscale = layer == 0 ? 8 : 9; E.scale0 = QSCALE; E.gate_tile = -1; E.gate = GATE; E.P = PP;
                    E.O1 = KVB + (size_t)layer * TMEM * CR_KV; E.ld1 = CR_KV;
                    pg8::gemm_phase<pg8::EpiProj>(lds, g, S, E);
                }
                SEAM_X
                PHASE_BEGIN
                if (layer == 0) {
                    for (int i = 0;; ++i) {
                        const int p = i * T.nloc + ((i & 1) ? (T.nloc - 1 - T.k) : T.k);
                        if (p >= T.NB * 128) break;
                        const int qb = 7 - p / (16 * T.NB), rest = p % (16 * T.NB), b = T.b0 + (rest >> 4), h = rest & 15;
                        att::Args a; a.Q = ACT + h * 128; a.K = ACT + 2048 + h * 128; a.V = ACT + 4096 + h * 128; a.O = HB + h * 128; a.lse = nullptr;
                        a.q_pitch = ACT_LD; a.kv_pitch = ACT_LD; a.o_pitch = HB_LD; a.lse_pitch = 0; a.q_tok0 = b * SEQ; a.k_tok0 = b * SEQ; a.dil = 1; a.logL = 20;
                        a.q0 = 256 * qb; a.kt_lo = 0; a.kt_hi = 4 * (qb + 1); a.aux = GATE + h; a.bf = ((const GAS float*)args.in[7])[h];
                        att::unit<1>(lds, a);
                    }
                } else {
                    for (int i = 0;; ++i) {
                        const int p = i * T.nloc + T.k;
                        if (p >= T.NB * 144) break;
                        const int grp = p / (48 * T.NB), rr = p % (48 * T.NB), b = T.b0 + rr / 48, r = rr % 48, gh = r >> 3, sub = r & 7;
                        int rho = 0, q0 = 0, dil, logL;
                        if (grp == 0) { dil = 1; logL = 11; q0 = 256 * sub; }
                        else if (grp == 1) { rho = sub >> 1; dil = 4; logL = 9; q0 = 256 * (sub & 1); }
                        else { rho = 2 * sub; dil = 16; logL = 7; q0 = 0; }
                        const int head = grp * 6 + gh;
                        att::Args a; a.Q = ACT + head * 128; a.K = ACT + DIL_HD + head * 128; a.V = ACT + 2 * DIL_HD + head * 128; a.O = HB + head * 128; a.lse = LSE + head;
                        a.q_pitch = ACT_LD; a.kv_pitch = ACT_LD; a.o_pitch = HB_LD; a.lse_pitch = DILH; a.q_tok0 = b * SEQ + rho; a.k_tok0 = b * SEQ + rho; a.dil = dil; a.logL = logL;
                        a.q0 = q0; a.kt_lo = (q0 >= 128 ? q0 - 128 : 0) >> 6; a.kt_hi = (q0 + 256) >> 6; a.aux = args.in[11] + head; a.bf = 0.f;
                        att::unit<2>(lds, a);
                    }
                }
                SEAM_X
                if (layer == 1) {
                    PHASE_BEGIN
                    int tid_l = tid; asm volatile("" : "+v"(tid_l));
                    const long i0 = T.fast ? (long)(256 * T.pm + 64 * T.member) * 288 + tid_l : (long)bx * 512 + tid_l;
                    const long i1 = T.fast ? (long)(256 * T.pm + 64 * T.member + 64) * 288 : (long)TOK * 288, istep = T.fast ? 512 : (long)G * 512;
                    for (long idx = i0; idx < i1; idx += istep) {
                        const int t = (int)(idx / 288), cc = (int)(idx % 288), head = cc >> 4, gh = head % 6, grp = head / 6;
                        const GAS float* lsg = (const GAS float*)LSE; const float l0 = lsg[(size_t)t * DILH + gh], l1 = lsg[(size_t)t * DILH + 6 + gh], l2 = lsg[(size_t)t * DILH + 12 + gh];
                        const float mx = fmaxf(l0, fmaxf(l1, l2)); const float e0 = expf(l0 - mx), e1 = expf(l1 - mx), e2 = expf(l2 - mx);
                        const float al = (grp == 0 ? e0 : (grp == 1 ? e1 : e2)) / (e0 + e1 + e2);
                        GAS u32x4* p = (GAS u32x4*)(HB + (size_t)t * DIL_HD + cc * 8); u32x4 v = *p;
                        v.x = cvt_pk_bf16(bf_lo(v.x) * al, bf_hi(v.x) * al); v.y = cvt_pk_bf16(bf_lo(v.y) * al, bf_hi(v.y) * al); v.z = cvt_pk_bf16(bf_lo(v.z) * al, bf_hi(v.z) * al); v.w = cvt_pk_bf16(bf_lo(v.w) * al, bf_hi(v.w) * al);
                        *p = v;
                    }
                    SEAM_P
                }
                PHASE_BEGIN
                {
                    pg8::GemmSet g; g.A0 = HB; g.B0 = (const bf16_t*)(ws + (layer == 0 ? WS_FOX_OUT : WS_DIL_OUT)); g.A1 = nullptr; g.B1 = nullptr; g.K = layer == 0 ? DM : DIL_HD; g.lda = HB_LD;
                    pg8::Order S; S.init(TOK, DM, 0, 0, G, bx);
                    pg8::EpiResid E; E.base32 = nullptr; E.xb = XB; E.out32 = nullptr; E.alpha = 1.0f; E.P = PP;
                    pg8::gemm_phase<pg8::EpiResid>(lds, g, S, E);
                }
                SEAM_P
                PHASE_BEGIN
                {
                    pg8::GemmSet g; g.A0 = XB; g.B0 = (const bf16_t*)(ws + WS_CQ_W + (size_t)layer * 2 * MiB); g.A1 = MEMN; g.B1 = (const bf16_t*)(ws + WS_CKV_W); g.K = DM; g.lda = DM;
                    pg8::Order S; if (layer == 0) S.init(TOK, CR_HD, TMEM, CR_KV, G, bx); else S.init(TOK, CR_HD, 0, 0, G, bx);
                    pg8::EpiProj E; E.O0 = CQ; E.ld0 = CR_HD; E.nscale = 2; E.scale0 = QSCALE; E.gate_tile = -1; E.gate = nullptr; E.O1 = KVB; E.ld1 = CR_KV; E.P = PP;
                    pg8::gemm_phase<pg8::EpiProj>(lds, g, S, E);
                }
                if (layer == 0) group_barrier(T.xcnt, T.nx, T.wb); else group_barrier(T.pcnt, T.np, T.wb); }
                PHASE_BEGIN
                for (int i = 0;; ++i) {
                    const int p = i * T.nloc + T.k;
                    if (p >= T.NB * 32) break;
                    const int qb = p & 7, h = (p >> 3) & 3, b = T.b0 + (p >> 5);
                    const bf16_t* kv = KVB + (size_t)layer * TMEM * CR_KV;
                    att::Args a; a.Q = CQ + h * 128; a.K = kv + h * 128; a.V = kv + CR_HD + h * 128; a.O = CO + h * 128; a.lse = nullptr;
                    a.q_pitch = CR_HD; a.kv_pitch = CR_KV; a.o_pitch = CR_HD; a.lse_pitch = 0; a.q_tok0 = b * SEQ; a.k_tok0 = b * NMEM; a.dil = 1; a.logL = 20;
                    a.q0 = 256 * qb; a.kt_lo = 0; a.kt_hi = 4; a.aux = nullptr; a.bf = 0.f;
                    att::unit<0>(lds, a);
                }
                SEAM_P
                PHASE_BEGIN
                {
                    pg8::GemmSet g; g.A0 = CO; g.B0 = (const bf16_t*)(ws + WS_CO_W + (size_t)layer * 2 * MiB); g.A1 = nullptr; g.B1 = nullptr; g.K = CR_HD; g.lda = CR_HD;
                    pg8::Order S; S.init(TOK, DM, 0, 0, G, bx);
                    pg8::EpiResid E; E.base32 = nullptr; E.xb = XB; E.out32 = nullptr; E.alpha = 1.0f; E.P = PP;
                    pg8::gemm_phase<pg8::EpiResid>(lds, g, S, E);
                }
                SEAM_P
}
template <int layer, int f> __device__ __forceinline__ void ffn_phases(PH_PARAMS) {
            PHASE_BEGIN
            {
                pg8::GemmSet g; g.A0 = XB; g.B0 = (const bf16_t*)(ws + WS_FFN_IN + (size_t)(2 * layer + f) * SZ_FFN_IN); g.A1 = nullptr; g.B1 = nullptr; g.K = DM; g.lda = DM;
                pg8::Order S; S.init(TOK, 2 * DFF, 0, 0, G, bx);
                pg8::EpiSwiglu E; E.O = ACT; E.P = PP;
                pg8::gemm_phase<pg8::EpiSwiglu>(lds, g, S, E);
            }
            SEAM_P
            PHASE_BEGIN
            {
                pg8::GemmSet g; g.A0 = ACT; g.B0 = (const bf16_t*)(ws + WS_FFN_OUT + (size_t)(2 * layer + f) * SZ_FFN_OUT); g.A1 = nullptr; g.B1 = nullptr; g.K = DFF; g.lda = ACT_LD;
                pg8::Order S; S.init(TOK, DM, 0, 0, G, bx);
                pg8::EpiResid E; E.base32 = (layer == 0 && f == 0) ? args.in[0] : nullptr; E.xb = XB; E.out32 = (layer == 1 && f == 1) ? xr : nullptr; E.alpha = 0.5f; E.P = PP;
                pg8::gemm_phase<pg8::EpiResid>(lds, g, S, E);
            }
            SEAM_P
}

__global__ void __launch_bounds__(512, 2) fwd_megakernel(KArgs args) {
    extern __shared__ __attribute__((aligned(16))) unsigned char lds_raw[];
    LAS unsigned char* lds = (LAS unsigned char*)lds_raw;
    cg::grid_group grid = cg::this_grid();
    const int tid = threadIdx.x, lane = tid & 63, wave = __builtin_amdgcn_readfirstlane(tid >> 6);
    const int G = gridDim.x, bx = blockIdx.x;
    const int gw = bx * 8 + wave, ngw = G * 8;
    unsigned* ctl = (unsigned*)(args.ws + WS_BAR);
    if (bx == 0) for (int i = tid; i < 8192; i += 512) __hip_atomic_store(ctl + i, 0u, __ATOMIC_RELAXED, __HIP_MEMORY_SCOPE_AGENT);
    if (tid == 0) __hip_atomic_store(ctl + 8192 + bx, xb_xcc_id() + 1u, __ATOMIC_RELAXED, __HIP_MEMORY_SCOPE_AGENT);
    PHASE_BEGIN
    {
        LAS float* scr = (LAS float*)(lds + wave * 16384);
        convert_matrix(args.in[19] + (size_t)DFF * DM, DFF, DM, (bf16_t*)(ws + WS_FFN_OUT + (size_t)3 * SZ_FFN_OUT), 0, nullptr, scr, gw, ngw, lane);
        convert_matrix(args.in[18] + (size_t)DM * 2 * DFF, DM, 2 * DFF, (bf16_t*)(ws + WS_FFN_IN + (size_t)3 * SZ_FFN_IN), 1, args.in[17] + DM, scr, gw, ngw, lane);
        convert_matrix(args.in[16] + (size_t)CR_HD * DM, CR_HD, DM, (bf16_t*)(ws + WS_CO_W + (size_t)2 * MiB), 0, nullptr, scr, gw, ngw, lane);
        convert_matrix(args.in[14] + (size_t)DM * CR_HD, DM, CR_HD, (bf16_t*)(ws + WS_CQ_W + (size_t)2 * MiB), 0, args.in[12] + DM, scr, gw, ngw, lane);
        convert_matrix(args.in[10], DIL_HD, DM, (bf16_t*)(ws + WS_DIL_OUT), 0, nullptr, scr, gw, ngw, lane);
        convert_matrix(args.in[15] + (size_t)DM * CR_KV, DM, CR_KV, (bf16_t*)(ws + WS_CKV_W + (size_t)4 * MiB), 0, nullptr, scr, gw, ngw, lane);
        convert_matrix(args.in[9], DM, DIL_N, (bf16_t*)(ws + WS_DIL_IN), 0, args.in[5] + DM, scr, gw, ngw, lane);
        convert_matrix(args.in[4] + (size_t)DFF * DM, DFF, DM, (bf16_t*)(ws + WS_FFN_OUT + (size_t)2 * SZ_FFN_OUT), 0, nullptr, scr, gw, ngw, lane);
        convert_matrix(args.in[3] + (size_t)DM * 2 * DFF, DM, 2 * DFF, (bf16_t*)(ws + WS_FFN_IN + (size_t)2 * SZ_FFN_IN), 1, args.in[2] + DM, scr, gw, ngw, lane);
        convert_matrix(args.in[19], DFF, DM, (bf16_t*)(ws + WS_FFN_OUT + (size_t)1 * SZ_FFN_OUT), 0, nullptr, scr, gw, ngw, lane);
        convert_matrix(args.in[18], DM, 2 * DFF, (bf16_t*)(ws + WS_FFN_IN + (size_t)1 * SZ_FFN_IN), 1, args.in[17], scr, gw, ngw, lane);
        convert_matrix(args.in[16], CR_HD, DM, (bf16_t*)(ws + WS_CO_W), 0, nullptr, scr, gw, ngw, lane);
        convert_matrix(args.in[15], DM, CR_KV, (bf16_t*)(ws + WS_CKV_W), 0, nullptr, scr, gw, ngw, lane);
        convert_matrix(args.in[14], DM, CR_HD, (bf16_t*)(ws + WS_CQ_W), 0, args.in[12], scr, gw, ngw, lane);
        convert_matrix(args.in[8], DM, DM, (bf16_t*)(ws + WS_FOX_OUT), 0, nullptr, scr, gw, ngw, lane);
        convert_matrix(args.in[6], DM, FOX_N, (bf16_t*)(ws + WS_FOX_IN), 0, args.in[5], scr, gw, ngw, lane);
        convert_matrix(args.in[4], DFF, DM, (bf16_t*)(ws + WS_FFN_OUT), 0, nullptr, scr, gw, ngw, lane);
        convert_matrix(args.in[3], DM, 2 * DFF, (bf16_t*)(ws + WS_FFN_IN), 1, args.in[2], scr, gw, ngw, lane);
        rms_rows_bf16(args.in[1], args.in[13], MEMN, DM, TMEM, gw, ngw, lane);
        rows_to_xb(args.in[0], XB, PP, TOK, gw, ngw, lane);
    }
    grid.sync(); }
    Topo T;
    T.fast = (G == 256);
    if (T.fast) {
        const int xcd = bx & 7, kk = bx >> 3;
        T.b0 = xcd; T.NB = 1; T.nloc = 32; T.k = kk; T.pm = 8 * xcd + (kk & 7); T.member = kk >> 3;
        T.xcnt = ctl + 64 * xcd; T.pcnt = ctl + 64 * (8 + T.pm); T.nx = 32u; T.np = 4u;
        const unsigned mine = __hip_atomic_load(ctl + 8192 + bx, __ATOMIC_RELAXED, __HIP_MEMORY_SCOPE_AGENT); int same = 1;
        for (int j = 0; j < 32; ++j) same &= (__hip_atomic_load(ctl + 8192 + xcd + 8 * j, __ATOMIC_RELAXED, __HIP_MEMORY_SCOPE_AGENT) == mine) ? 1 : 0;
        T.wb = __builtin_amdgcn_readfirstlane(same) ? 0 : 1;
    } else {
        T.b0 = 0; T.NB = 8; T.nloc = G; T.k = bx; T.pm = 0; T.member = 0;
        T.xcnt = ctl + 64 * 100; T.pcnt = T.xcnt; T.nx = (unsigned)G; T.np = (unsigned)G; T.wb = 1;
    }
    ffn_phases<0, 0>(PH_ARGS);
    mixer_phases<0>(PH_ARGS);
    ffn_phases<0, 1>(PH_ARGS);
    ffn_phases<1, 0>(PH_ARGS);
    mixer_phases<1>(PH_ARGS);
    ffn_phases<1, 1>(PH_ARGS);
    PHASE_BEGIN
    if (T.fast) rms_rows_f32_inplace(xr + (size_t)(256 * T.pm + 64 * T.member) * DM, args.in[20], 64, wave, 8, lane);
    else rms_rows_f32_inplace(xr, args.in[20], TOK, gw, ngw, lane);
    PHASE_END_LAST
}

extern "C" void kernel_launch(void* const* d_in, const int* in_sizes, int n_in, void* d_out, int out_size, void* d_ws, size_t ws_size, hipStream_t stream) {
    static int grid = 0;
    if (grid == 0) {
        if (n_in != 21 || out_size != TOK * DM || ws_size < WS_END) { fprintf(stderr, "kernel_launch: unexpected problem (n_in %d out %d ws %zu need %zu)\n", n_in, out_size, ws_size, (size_t)WS_END); grid = -1; return; }
        int dev = 0, cus = 0, per_cu = 0;
        if (hipGetDevice(&dev) != hipSuccess || hipDeviceGetAttribute(&cus, hipDeviceAttributeMultiprocessorCount, dev) != hipSuccess) { grid = -1; return; }
        if (hipFuncSetAttribute((const void*)fwd_megakernel, hipFuncAttributeMaxDynamicSharedMemorySize, LDS_BYTES) != hipSuccess) { fprintf(stderr, "kernel_launch: hipFuncSetAttribute failed\n"); grid = -1; return; }
        if (hipOccupancyMaxActiveBlocksPerMultiprocessor(&per_cu, (const void*)fwd_megakernel, 512, LDS_BYTES) != hipSuccess || per_cu < 1) { fprintf(stderr, "kernel_launch: occupancy query says %d\n", per_cu); per_cu = 1; }
        (void)hipGetLastError();
        grid = cus * per_cu;
    }
    if (grid < 0) return;
    KArgs a{};
    for (int i = 0; i < 21; ++i) a.in[i] = (const float*)d_in[i];
    a.out = (float*)d_out; a.ws = (unsigned char*)d_ws;
    void* kargs[] = {&a};
    hipError_t e = hipLaunchCooperativeKernel((const void*)fwd_megakernel, dim3(grid), dim3(512), kargs, LDS_BYTES, stream);
    if (e != hipSuccess) fprintf(stderr, "kernel_launch: cooperative launch failed: %s (grid %d)\n", hipGetErrorString(e), grid);
}
```

```cpp
#include <hip/hip_runtime.h>
#include <hip/hip_cooperative_groups.h>
#include <cstdio>
#include <cstdint>
namespace cg = cooperative_groups;

#define LAS __attribute__((address_space(3)))
#define GAS __attribute__((address_space(1)))
typedef unsigned short bf16_t;
typedef short bf16x8 __attribute__((ext_vector_type(8)));
typedef float f32x4 __attribute__((ext_vector_type(4)));
typedef float f32x16 __attribute__((ext_vector_type(16)));
typedef unsigned u32x4 __attribute__((ext_vector_type(4)));
typedef unsigned u32x2 __attribute__((ext_vector_type(2)));

constexpr int BATCH = 8, SEQ = 2048, DM = 2048, TOK = BATCH * SEQ, NMEM = 256, TMEM = BATCH * NMEM;
constexpr int FOXH = 16, DILH = 18, CRH = 4, DFF = 5632;
constexpr int FOX_N = 6160, FOX_QKV = 6144, DIL_N = 6912, DIL_HD = 2304, CR_HD = 512, CR_KV = 1024;
constexpr int ACT_LD = 6912, HB_LD = 2304;
constexpr float LOG2E = 1.4426950408889634f, LN2 = 0.6931471805599453f;
constexpr float QSCALE = 0.08838834764831845f * 1.4426950408889634f;
constexpr float RMS_EPS = 1e-6f;

constexpr size_t MiB = 1u << 20;
constexpr size_t SZ_FFN_IN = 44 * MiB, SZ_FFN_OUT = 22 * MiB;
constexpr size_t WS_FFN_IN = 0;
constexpr size_t WS_FFN_OUT = WS_FFN_IN + 4 * SZ_FFN_IN;
constexpr size_t WS_FOX_IN = WS_FFN_OUT + 4 * SZ_FFN_OUT;
constexpr size_t WS_FOX_OUT = WS_FOX_IN + 25 * MiB;
constexpr size_t WS_DIL_IN = WS_FOX_OUT + 8 * MiB;
constexpr size_t WS_DIL_OUT = WS_DIL_IN + 27 * MiB;
constexpr size_t WS_CQ_W = WS_DIL_OUT + 9 * MiB;
constexpr size_t WS_CKV_W = WS_CQ_W + 4 * MiB;
constexpr size_t WS_CO_W = WS_CKV_W + 8 * MiB;
constexpr size_t WS_MEMN = WS_CO_W + 4 * MiB;
constexpr size_t WS_KV = WS_MEMN + 8 * MiB;
constexpr size_t WS_HB = WS_KV + 8 * MiB;
constexpr size_t WS_ACT = WS_HB + 72 * MiB;
constexpr size_t WS_CQ = WS_ACT + 216 * MiB;
constexpr size_t WS_CO = WS_CQ + 16 * MiB;
constexpr size_t WS_GATE = WS_CO + 16 * MiB;
constexpr size_t WS_LSE = WS_GATE + 1 * MiB;
constexpr size_t WS_XB = WS_LSE + 2 * MiB;
constexpr size_t WS_P = WS_XB + 64 * MiB;
constexpr size_t WS_BAR = WS_P + 2 * MiB;
constexpr size_t WS_END = WS_BAR + 1 * MiB;

constexpr int LDS_BYTES = 149504;

__device__ __forceinline__ unsigned cvt_pk_bf16(float lo, float hi) {
    typedef float f2 __attribute__((ext_vector_type(2))); typedef __bf16 b2 __attribute__((ext_vector_type(2)));
    f2 v = {lo, hi}; b2 b = __builtin_convertvector(v, b2); return __builtin_bit_cast(unsigned, b);
}
__device__ __forceinline__ float bf_lo(unsigned w) { return __uint_as_float(w << 16); }
__device__ __forceinline__ float bf_hi(unsigned w) { return __uint_as_float(w & 0xffff0000u); }
__device__ __forceinline__ float wave_sum(float v) {
#pragma unroll
    for (int o = 1; o < 64; o <<= 1) v += __shfl_xor(v, o);
    return v;
}

namespace pg8 {
constexpr int BM = 256, BK = 64, HALF = 128, HTB = HALF * BK * 2, STAGE_BYTES = 8 * HTB, NXCD = 8, WGM = 8;
__device__ __forceinline__ int lds_byte(int r, int c) { const int st = (r >> 4) * 2 + (c >> 5), rr = r & 15, cc = c & 31, ob = rr * 64 + cc * 2; return st * 1024 + (ob ^ (((ob >> 9) & 1) << 5)); }
__device__ __forceinline__ void stage_rc(int b, int& R, int& C) { const int st = b / 1024, sb = b % 1024, swz = sb ^ (((sb >> 9) & 1) << 5); R = (st >> 1) * 16 + swz / 64; C = (st & 1) * 32 + (swz % 64) / 2; }
__device__ __forceinline__ int perm32(int rho) { const int n = rho >> 4, i = rho & 15; return 8 * (i >> 2) + 4 * n + (i & 3); }

struct Unit { int pm, pn, g; };
struct GemmSet { const bf16_t* A0; const bf16_t* B0; const bf16_t* A1; const bf16_t* B1; int K; int lda; };

struct Order {
    int nM0, nN0, nwg0, nM1, nwg1, G, c;
    __device__ void init(int M0, int N0, int M1, int N1, int G_, int c_) { nM0 = M0 / BM; nN0 = N0 / BM; nwg0 = nM0 * nN0; nM1 = M1 / BM; nwg1 = nM1 * (N1 / BM); G = G_; c = c_; }
    __device__ bool next(int i, Unit& u) const {
        long L = (long)i * G + c;
        if (L < nwg0) {
            int wgid = (int)L; { const int q = nwg0 / NXCD, r = nwg0 % NXCD, xcd = wgid % NXCD, off = wgid / NXCD; wgid = (xcd < r ? xcd * (q + 1) : r * (q + 1) + (xcd - r) * q) + off; }
            const int nig = WGM * nN0, gid = wgid / nig, fm = gid * WGM, gsz = (nM0 - fm) < WGM ? (nM0 - fm) : WGM;
            u.pm = fm + ((wgid % nig) % gsz); u.pn = (wgid % nig) / gsz; u.g = 0; return true;
        }
        L -= nwg0;
        if (L < nwg1) { u.pm = (int)(L % nM1); u.pn = (int)(L / nM1); u.g = 1; return true; }
        return false;
    }
};

__device__ __forceinline__ float silu_f(float x) { return x * __builtin_amdgcn_rcpf(1.0f + __builtin_amdgcn_exp2f(-LOG2E * x)); }

__device__ __forceinline__ void row_rstd(const float* P, int pm, int row0, int fq, int lane, LAS float* cache, int& tag, float (&rs)[2][4]) {
    if (!P) {
#pragma unroll
        for (int ai = 0; ai < 2; ++ai)
#pragma unroll
            for (int m = 0; m < 4; ++m) rs[ai][m] = 1.0f;
        return;
    }
    if (tag != pm) {
        tag = pm;
#pragma unroll
        for (int ai = 0; ai < 2; ++ai)
#pragma unroll
            for (int m = 0; m < 4; ++m) {
                const float* pp = P + (size_t)(row0 + ai * HALF + m * 16) * 32 + fq * 8; const f32x4 a = *(const GAS f32x4*)pp, b = *(const GAS f32x4*)(pp + 4);
                float s = ((a.x + a.y) + (a.z + a.w)) + ((b.x + b.y) + (b.z + b.w)); s += __shfl_xor(s, 16); s += __shfl_xor(s, 32);
                rs[ai][m] = __builtin_amdgcn_rsqf(s * (1.0f / DM) + RMS_EPS);
                cache[(ai * 4 + m) * 64 + lane] = rs[ai][m];
            }
    } else {
#pragma unroll
        for (int ai = 0; ai < 2; ++ai)
#pragma unroll
            for (int m = 0; m < 4; ++m) rs[ai][m] = cache[(ai * 4 + m) * 64 + lane];
    }
}
struct EpiSwiglu {
    static constexpr bool PERM = true;
    bf16_t* O; const float* P;
    __device__ __forceinline__ void operator()(const f32x4 (&acc)[2][2][4][2], const Unit& u, int wr, int wc, int fr, int fq, LAS float* cache, int& tag) const {
        const int row0 = u.pm * BM + wr * 64 + fr, col0 = u.pn * 128 + wc * 32 + 8 * fq;
        float rs[2][4]; row_rstd(P, u.pm, row0, fq, fr + 16 * fq, cache, tag, rs);
#pragma unroll
        for (int ai = 0; ai < 2; ++ai)
#pragma unroll
            for (int m = 0; m < 4; ++m) {
                bf16_t* rowp = O + (size_t)(row0 + ai * HALF + m * 16) * ACT_LD + col0; const float r = rs[ai][m];
                const float nrl = -LOG2E * r, r2 = r * r;
                const f32x4 ga = acc[ai][0][m][0], gb = acc[ai][0][m][1];
                const f32x4 pa = (ga * acc[ai][1][m][0]) * r2, pb = (gb * acc[ai][1][m][1]) * r2;
                const f32x4 ta = ga * nrl, tb = gb * nrl;
                f32x4 da, db;
#pragma unroll
                for (int j = 0; j < 4; ++j) { da[j] = __builtin_amdgcn_exp2f(ta[j]); db[j] = __builtin_amdgcn_exp2f(tb[j]); }
                da = da + 1.0f; db = db + 1.0f;
#pragma unroll
                for (int j = 0; j < 4; ++j) { da[j] = __builtin_amdgcn_rcpf(da[j]); db[j] = __builtin_amdgcn_rcpf(db[j]); }
                const f32x4 oa = pa * da, ob = pb * db;
                u32x4 w; w.x = cvt_pk_bf16(oa[0], oa[1]); w.y = cvt_pk_bf16(oa[2], oa[3]); w.z = cvt_pk_bf16(ob[0], ob[1]); w.w = cvt_pk_bf16(ob[2], ob[3]);
                *(GAS u32x4*)rowp = w;
            }
    }
};
struct EpiResid {
    static constexpr bool PERM = true;
    const float* base32; bf16_t* xb; float* out32; float alpha; float* P;
    __device__ __forceinline__ void operator()(const f32x4 (&acc)[2][2][4][2], const Unit& u, int wr, int wc, int fr, int fq, LAS float* cache, int& tag) const {
        const int row0 = u.pm * BM + wr * 64 + fr, col0 = u.pn * BM + wc * 32 + 8 * fq;
#pragma unroll
        for (int ai = 0; ai < 2; ++ai)
#pragma unroll
            for (int m = 0; m < 4; ++m) {
                const int row = row0 + ai * HALF + m * 16; const size_t off = (size_t)row * DM + col0; float ss = 0.f;
#pragma unroll
                for (int bj = 0; bj < 2; ++bj) {
                    f32x4 x0, x1;
                    if (base32) { x0 = *(const GAS f32x4*)(base32 + off + bj * HALF); x1 = *(const GAS f32x4*)(base32 + off + bj * HALF + 4); }
                    else { const u32x4 b = *(const GAS u32x4*)(xb + off + bj * HALF); x0 = (f32x4){bf_lo(b.x), bf_hi(b.x), bf_lo(b.y), bf_hi(b.y)}; x1 = (f32x4){bf_lo(b.z), bf_hi(b.z), bf_lo(b.w), bf_hi(b.w)}; }
                    x0 = x0 + acc[ai][bj][m][0] * alpha; x1 = x1 + acc[ai][bj][m][1] * alpha;
                    ss += ((x0.x * x0.x + x0.y * x0.y) + (x0.z * x0.z + x0.w * x0.w)) + ((x1.x * x1.x + x1.y * x1.y) + (x1.z * x1.z + x1.w * x1.w));
                    if (out32) { *(GAS f32x4*)(out32 + off + bj * HALF) = x0; *(GAS f32x4*)(out32 + off + bj * HALF + 4) = x1; }
                    else { u32x4 w; w.x = cvt_pk_bf16(x0.x, x0.y); w.y = cvt_pk_bf16(x0.z, x0.w); w.z = cvt_pk_bf16(x1.x, x1.y); w.w = cvt_pk_bf16(x1.z, x1.w); *(GAS u32x4*)(xb + off + bj * HALF) = w; }
                }
                ss += __shfl_xor(ss, 16); ss += __shfl_xor(ss, 32); if (fq == 0) ((GAS float*)P)[(size_t)row * 32 + u.pn * 4 + wc] = ss;
                if (m & 1) asm volatile("" ::: "memory");
            }
    }
};
struct EpiProj {
    static constexpr bool PERM = true;
    bf16_t* O0; int ld0; int nscale; float scale0; int gate_tile; float* gate; bf16_t* O1; int ld1; const float* P;
    __device__ __forceinline__ void operator()(const f32x4 (&acc)[2][2][4][2], const Unit& u, int wr, int wc, int fr, int fq, LAS float* cache, int& tag) const {
        const int row0 = u.pm * BM + wr * 64 + fr;
        float rs[2][4]; row_rstd(u.g ? nullptr : P, u.pm, row0, fq, fr + 16 * fq, cache, tag, rs);
        if (u.g == 0 && u.pn == gate_tile) {
            if (wc == 0 && fq < 2) {
#pragma unroll
                for (int ai = 0; ai < 2; ++ai)
#pragma unroll
                    for (int m = 0; m < 4; ++m) { float* gp = gate + (size_t)(row0 + ai * HALF + m * 16) * 16 + 8 * fq; *(GAS f32x4*)gp = acc[ai][0][m][0] * rs[ai][m]; *(GAS f32x4*)(gp + 4) = acc[ai][0][m][1] * rs[ai][m]; }
            }
            return;
        }
        bf16_t* base = u.g ? O1 : O0; const int ld = u.g ? ld1 : ld0; const float sc = (u.g == 0 && u.pn < nscale) ? scale0 : 1.0f;
        const int col0 = u.pn * BM + wc * 32 + 8 * fq;
#pragma unroll
        for (int ai = 0; ai < 2; ++ai)
#pragma unroll
            for (int m = 0; m < 4; ++m) {
                bf16_t* rowp = base + (size_t)(row0 + ai * HALF + m * 16) * ld + col0; const float r = sc * rs[ai][m];
#pragma unroll
                for (int bj = 0; bj < 2; ++bj) { const f32x4 v0 = acc[ai][bj][m][0] * r, v1 = acc[ai][bj][m][1] * r; u32x4 w; w.x = cvt_pk_bf16(v0[0], v0[1]); w.y = cvt_pk_bf16(v0[2], v0[3]); w.z = cvt_pk_bf16(v1[0], v1[1]); w.w = cvt_pk_bf16(v1[2], v1[3]);
                    *(GAS u32x4*)(rowp + bj * HALF) = w; }
            }
    }
};

template <class Epi>
__device__ __forceinline__ void gemm_phase(LAS unsigned char* lds, const GemmSet g, const Order& S, const Epi& E) {
    int tid = threadIdx.x; asm volatile("" : "+v"(tid));
    const int wid = __builtin_amdgcn_readfirstlane(tid >> 6), lane = tid & 63, wr = wid >> 2, wc = wid & 3, fr = lane & 15, fq = lane >> 4;
    const int K = g.K, nt = K / BK;
    unsigned voffA[2], voffB[2];
#pragma unroll
    for (int i = 0; i < 2; ++i) { int R, C; stage_rc(tid * 16 + i * 8192, R, C); const int Rb = Epi::PERM ? ((R & ~31) + perm32(R & 31)) : R;
        voffA[i] = (unsigned)(R * g.lda + C) * 2u; voffB[i] = (unsigned)(Rb * K + C) * 2u; }
    const size_t kstep = (size_t)(BK * 2);
    const size_t hstep = (size_t)HALF * K * 2;
    const size_t tstep = 2 * hstep;
    const size_t hstepA = (size_t)HALF * g.lda * 2, tstepA = 2 * hstepA;
    const unsigned ldsw = (unsigned)wid * 1024u;
    const int aoff = lds_byte(wr * 64 + fr, fq * 8), boff = lds_byte(wc * 32 + fr, fq * 8);
#define PG8_SA(b, h) (((b) * 2 + (h)) * HTB)
#define PG8_SB(b, h) ((4 + (b) * 2 + (h)) * HTB)
#define PG8_STAGE(bufoff, gbase, voff) do { _Pragma("unroll") for (int _i = 0; _i < 2; ++_i) \
        __builtin_amdgcn_global_load_lds((const unsigned*)((const char*)(gbase) + (voff)[_i]), (LAS unsigned*)(lds + (bufoff) + ldsw + _i * 8192), 16, 0, 0); } while (0)
#define PG8_LDA(dst, b, h) do { _Pragma("unroll") for (int m = 0; m < 4; ++m) _Pragma("unroll") for (int k = 0; k < 2; ++k) dst[m][k] = *(const LAS bf16x8*)(lds + PG8_SA(b, h) + aoff + m * 2048 + k * 1024); } while (0)
#define PG8_LDB(dst, b, h) do { _Pragma("unroll") for (int n = 0; n < 2; ++n) _Pragma("unroll") for (int k = 0; k < 2; ++k) dst[n][k] = *(const LAS bf16x8*)(lds + PG8_SB(b, h) + boff + n * 2048 + k * 1024); } while (0)
#define PG8_MMA(ai, bj, At, Bt) do { __builtin_amdgcn_s_setprio(1); _Pragma("unroll") for (int m = 0; m < 4; ++m) _Pragma("unroll") for (int n = 0; n < 2; ++n) _Pragma("unroll") for (int k = 0; k < 2; ++k) \
        acc[ai][bj][m][n] = __builtin_amdgcn_mfma_f32_16x16x32_bf16(Bt[n][k], At[m][k], acc[ai][bj][m][n], 0, 0, 0); __builtin_amdgcn_s_setprio(0); } while (0)
#define PG8_WAIT_V(n) asm volatile("s_waitcnt vmcnt(" #n ")" ::: "memory")
#define PG8_WAIT_L(n) asm volatile("s_waitcnt lgkmcnt(" #n ")" ::: "memory")
#define PG8_BAR __builtin_amdgcn_s_barrier()
#define PG8_SCHED __builtin_amdgcn_sched_barrier(0)
    Unit cur, nxt; int ui = 0;
    if (!S.next(0, cur)) return;
    LAS float* rcache = (LAS float*)(lds + STAGE_BYTES + 1024 + wid * 2048); int rtag = -1;
    f32x4 acc[2][2][4][2];
#pragma unroll
    for (int a = 0; a < 2; ++a)
#pragma unroll
        for (int b = 0; b < 2; ++b)
#pragma unroll
            for (int m = 0; m < 4; ++m)
#pragma unroll
                for (int n = 0; n < 2; ++n) acc[a][b][m][n] = (f32x4){0.f, 0.f, 0.f, 0.f};
    bf16x8 At[4][2], B0[2][2], B1[2][2];
    const char* cA = (const char*)(cur.g ? g.A1 : g.A0) + (size_t)cur.pm * tstepA; const char* cB = (const char*)(cur.g ? g.B1 : g.B0) + (size_t)cur.pn * tstep;
    PG8_STAGE(PG8_SB(0, 0), cB, voffB); PG8_STAGE(PG8_SB(0, 1), cB + hstep, voffB); PG8_STAGE(PG8_SA(0, 0), cA, voffA); PG8_STAGE(PG8_SA(0, 1), cA + hstepA, voffA);
    if (wr == 1) PG8_BAR;
    PG8_WAIT_V(2); PG8_BAR;
    PG8_STAGE(PG8_SB(1, 0), cB + kstep, voffB); PG8_STAGE(PG8_SA(1, 0), cA + kstep, voffA); PG8_STAGE(PG8_SB(1, 1), cB + hstep + kstep, voffB);
    PG8_WAIT_V(6); PG8_BAR;
    for (;;) {
        const bool has_next = S.next(ui + 1, nxt);
        const char* nA = has_next ? (const char*)(nxt.g ? g.A1 : g.A0) + (size_t)nxt.pm * tstepA : cA; const char* nB = has_next ? (const char*)(nxt.g ? g.B1 : g.B0) + (size_t)nxt.pn * tstep : cB;
        for (int t = 0; t < nt; t += 2) {
            const bool last = (t == nt - 2);
            const char* a1 = cA + (size_t)(t + 1) * kstep;
            const char* a2 = last ? nA : cA + (size_t)(t + 2) * kstep; const char* b2 = last ? nB : cB + (size_t)(t + 2) * kstep;
            const char* a3 = a2 + kstep; const char* b3 = b2 + kstep;
            PG8_LDB(B0, 0, 0); PG8_LDB(B1, 0, 1); PG8_SCHED; PG8_LDA(At, 0, 0); PG8_STAGE(PG8_SA(1, 1), a1 + hstepA, voffA);
            PG8_WAIT_V(8); PG8_WAIT_L(0); PG8_BAR; PG8_MMA(0, 0, At, B0); PG8_MMA(0, 1, At, B1); PG8_BAR; PG8_SCHED;
            PG8_LDA(At, 0, 1); PG8_STAGE(PG8_SB(0, 0), b2, voffB); PG8_STAGE(PG8_SB(0, 1), b2 + hstep, voffB); PG8_STAGE(PG8_SA(0, 0), a2, voffA);
            PG8_WAIT_V(8); PG8_WAIT_L(0); PG8_BAR; PG8_MMA(1, 0, At, B0); PG8_MMA(1, 1, At, B1); PG8_BAR; PG8_SCHED;
            PG8_LDB(B0, 1, 0); PG8_LDB(B1, 1, 1); PG8_SCHED; PG8_LDA(At, 1, 0); PG8_STAGE(PG8_SA(0, 1), a2 + hstepA, voffA);
            PG8_WAIT_V(8); PG8_WAIT_L(0); PG8_BAR; PG8_MMA(0, 0, At, B0); PG8_MMA(0, 1, At, B1); PG8_BAR; PG8_SCHED;
            PG8_LDA(At, 1, 1); PG8_STAGE(PG8_SB(1, 0), b3, voffB); PG8_STAGE(PG8_SB(1, 1), b3 + hstep, voffB); PG8_STAGE(PG8_SA(1, 0), a3, voffA);
            PG8_WAIT_V(8); PG8_WAIT_L(0); PG8_BAR; PG8_MMA(1, 0, At, B0); PG8_MMA(1, 1, At, B1); PG8_BAR; PG8_SCHED;
        }
        if (wr == 0) PG8_BAR;
        E(acc, cur, wr, wc, fr, fq, rcache, rtag);
        if (!has_next) break;
#pragma unroll
        for (int a = 0; a < 2; ++a)
#pragma unroll
            for (int b = 0; b < 2; ++b)
#pragma unroll
                for (int m = 0; m < 4; ++m)
#pragma unroll
                    for (int n = 0; n < 2; ++n) acc[a][b][m][n] = (f32x4){0.f, 0.f, 0.f, 0.f};
        cur = nxt; cA = nA; cB = nB; ++ui;
        if (wr == 1) PG8_BAR;
    }
    PG8_WAIT_V(0);
    PG8_BAR;
#undef PG8_SA
#undef PG8_SB
#undef PG8_STAGE
#undef PG8_LDA
#undef PG8_LDB
#undef PG8_MMA
#undef PG8_WAIT_V
#undef PG8_WAIT_L
#undef PG8_BAR
#undef PG8_SCHED
}
}

namespace att {
constexpr int KROW = 272, VROW = 144, KBUF = 64 * KROW, VBUF = 128 * VROW;
constexpr int OFF_K = 0, OFF_V = 3 * KBUF, OFF_BIAS = OFF_V + 2 * VBUF, OFF_RED = OFF_BIAS + 8192;
struct Args {
    const bf16_t* Q; const bf16_t* K; const bf16_t* V; bf16_t* O; float* lse;
    int q_pitch, kv_pitch, o_pitch, lse_pitch;
    int q_tok0, k_tok0, dil, logL;
    int q0, kt_lo, kt_hi;
    const float* aux; float bf;
};
__device__ __forceinline__ int crow(int r, int hi) { return (r & 3) + 8 * (r >> 2) + 4 * hi; }

__device__ __forceinline__ void att_qk(LAS unsigned char* lds, const int kbuf, const bf16x8 (&qf)[8], f32x16& s0, f32x16& s1, const int r32, const int hi) {
#pragma unroll
    for (int r = 0; r < 16; ++r) { s0[r] = 0.f; s1[r] = 0.f; }
    const LAS unsigned char* kb = lds + OFF_K + kbuf * KBUF + r32 * KROW + hi * 16;
#pragma unroll
    for (int ks = 0; ks < 8; ++ks) {
        const bf16x8 a0 = *(const LAS bf16x8*)(kb + ks * 32); const bf16x8 a1 = *(const LAS bf16x8*)(kb + 32 * KROW + ks * 32);
        s0 = __builtin_amdgcn_mfma_f32_32x32x16_bf16(a0, qf[ks], s0, 0, 0, 0); s1 = __builtin_amdgcn_mfma_f32_32x32x16_bf16(a1, qf[ks], s1, 0, 0, 0);
    }
}
template <int MODE>
__device__ __forceinline__ void att_smpv(LAS unsigned char* lds, const int vbuf, const int klo, const bool need_mask, f32x16& s0, f32x16& s1, f32x16 (&o)[4], float& mrun, float& lrun,
                                         const LAS float* bl, const int qp, const int r32, const int hi) {
    if (MODE == 1) {
#pragma unroll
        for (int g4 = 0; g4 < 4; ++g4) { const f32x4 b0 = *(const LAS f32x4*)(bl + klo + 8 * g4 + 4 * hi), b1 = *(const LAS f32x4*)(bl + klo + 32 + 8 * g4 + 4 * hi);
#pragma unroll
            for (int j = 0; j < 4; ++j) { s0[4 * g4 + j] += b0[j]; s1[4 * g4 + j] += b1[j]; } }
        if (need_mask) {
#pragma unroll
            for (int r = 0; r < 16; ++r) { const int kp0 = klo + crow(r, hi); if (kp0 > qp) s0[r] = -1e30f; if (kp0 + 32 > qp) s1[r] = -1e30f; }
        }
    }
    if (MODE == 2) {
        const LAS float* tb = bl + (qp - klo - 4 * hi + 96 - 59);
#pragma unroll
        for (int r = 0; r < 16; ++r) { const int c = (r & 3) + 8 * (r >> 2); s0[r] += tb[59 - c]; s1[r] += tb[59 - c - 32]; }
    }
#define MX3(a_, b_, c_) __builtin_fmaxf(__builtin_fmaxf((a_), (b_)), (c_))
    float ma = MX3(s0[0], s0[1], s1[0]), mb = MX3(s0[2], s0[3], s1[1]); ma = MX3(ma, s1[2], s1[3]);
#pragma unroll
    for (int r = 4; r < 16; r += 4) { ma = MX3(ma, s0[r], s0[r + 1]); mb = MX3(mb, s0[r + 2], s0[r + 3]); ma = MX3(ma, s1[r], s1[r + 1]); mb = MX3(mb, s1[r + 2], s1[r + 3]); }
#undef MX3
    float rm = fmaxf(ma, mb);
    rm = fmaxf(rm, __shfl_xor(rm, 32));
    const float mn = fmaxf(mrun, rm); const float alpha = __builtin_amdgcn_exp2f(mrun - mn); mrun = mn;
    float ps = 0.f;
#pragma unroll
    for (int r = 0; r < 16; ++r) { s0[r] = __builtin_amdgcn_exp2f(s0[r] - mn); s1[r] = __builtin_amdgcn_exp2f(s1[r] - mn); ps += s0[r] + s1[r]; }
    lrun = lrun * alpha + ps;
    if (__any(alpha != 1.0f)) {
#pragma unroll
        for (int db = 0; db < 4; ++db)
#pragma unroll
            for (int r = 0; r < 16; ++r) o[db][r] *= alpha;
    }
    bf16x8 pj[4];
#pragma unroll
    for (int jj = 0; jj < 2; ++jj) {
        u32x4 w0, w1;
        w0.x = cvt_pk_bf16(s0[8 * jj + 0], s0[8 * jj + 1]); w0.y = cvt_pk_bf16(s0[8 * jj + 2], s0[8 * jj + 3]); w0.z = cvt_pk_bf16(s0[8 * jj + 4], s0[8 * jj + 5]); w0.w = cvt_pk_bf16(s0[8 * jj + 6], s0[8 * jj + 7]);
        w1.x = cvt_pk_bf16(s1[8 * jj + 0], s1[8 * jj + 1]); w1.y = cvt_pk_bf16(s1[8 * jj + 2], s1[8 * jj + 3]); w1.z = cvt_pk_bf16(s1[8 * jj + 4], s1[8 * jj + 5]); w1.w = cvt_pk_bf16(s1[8 * jj + 6], s1[8 * jj + 7]);
        pj[jj] = __builtin_bit_cast(bf16x8, w0); pj[2 + jj] = __builtin_bit_cast(bf16x8, w1);
    }
    const LAS unsigned char* vb = lds + OFF_V + vbuf * VBUF + r32 * VROW + hi * 16;
#pragma unroll
    for (int db = 0; db < 4; ++db)
#pragma unroll
        for (int j = 0; j < 4; ++j) { const bf16x8 va = *(const LAS bf16x8*)(vb + db * 32 * VROW + j * 32); o[db] = __builtin_amdgcn_mfma_f32_32x32x16_bf16(va, pj[j], o[db], 0, 0, 0); }
}

template <int MODE>
__device__ __forceinline__ void unit(LAS unsigned char* lds, const Args& a) {
    int tid = threadIdx.x; asm volatile("" : "+v"(tid));
    const int lane = tid & 63, wid = __builtin_amdgcn_readfirstlane(tid >> 6), r32 = lane & 31, hi = lane >> 5;
    const int Lm1 = (1 << a.logL) - 1;
#define ATOK(base, p) ((base) + ((p) >> a.logL) + ((p) & Lm1) * a.dil)
    LAS float* bl = (LAS float*)(lds + OFF_BIAS);
    if (MODE == 1) {
        LAS float* red = (LAS float*)(lds + OFF_RED);
        const float* gz = a.aux + (size_t)a.k_tok0 * 16;
        float v[4];
#pragma unroll
        for (int e = 0; e < 4; ++e) { const float y = ((const GAS float*)gz)[(size_t)(4 * tid + e) * 16] + a.bf; v[e] = fminf(y, 0.f) - log1pf(expf(-fabsf(y))); }
        v[1] += v[0]; v[2] += v[1]; v[3] += v[2];
        const float tot = v[3]; float sc = tot;
#pragma unroll
        for (int o = 1; o < 64; o <<= 1) { const float n = __shfl_up(sc, o); if (lane >= o) sc += n; }
        if (lane == 63) red[wid] = sc;
        __syncthreads();
        float woff = 0.f;
        for (int w = 0; w < wid; ++w) woff += red[w];
        const float excl = woff + sc - tot;
#pragma unroll
        for (int e = 0; e < 4; ++e) bl[4 * tid + e] = -(excl + v[e]) * LOG2E;
    } else if (MODE == 2) {
        if (tid < 320) bl[tid] = -1e30f;
        __syncthreads();
        if (tid <= 128) {
            const int d = tid * a.dil; int bucket;
            if (d < 16) bucket = d;
            else {
                bucket = 16 + (d >= 22) + (d >= 30) + (d >= 40) + (d >= 54) + (d >= 73) + (d >= 99) + (d >= 134) + (d >= 182) + (d >= 246) + (d >= 332) + (d >= 450) + (d >= 609) + (d >= 825) + (d >= 1117) + (d >= 1513);
            }
            bl[96 + tid] = ((const GAS float*)a.aux)[bucket * DILH] * LOG2E;
        }
    }
    const int qlo = a.q0 + 32 * wid, qp = qlo + r32;
    const size_t qtok = (size_t)ATOK(a.q_tok0, qp);
    bf16x8 qf[8];
    { const bf16_t* qrow = a.Q + qtok * a.q_pitch + 8 * hi;
#pragma unroll
      for (int ks = 0; ks < 8; ++ks) qf[ks] = *(const GAS bf16x8*)(qrow + 16 * ks); }
    f32x16 o[4];
#pragma unroll
    for (int db = 0; db < 4; ++db)
#pragma unroll
        for (int r = 0; r < 16; ++r) o[db][r] = 0.f;
    float mrun = -1e29f, lrun = 0.f;
    u32x4 kreg[2], vreg[2];
#define LOAD_K(kt) do { _Pragma("unroll") for (int i_ = 0; i_ < 2; ++i_) { const int id_ = tid + 512 * i_; const int row_ = id_ >> 4, ch_ = id_ & 15, kp_ = 64 * (kt) + row_; \
        kreg[i_] = *(const GAS u32x4*)(a.K + (size_t)ATOK(a.k_tok0, kp_) * a.kv_pitch + ch_ * 8); } } while (0)
#define LOAD_V(kt) do { _Pragma("unroll") for (int i_ = 0; i_ < 2; ++i_) { const int id_ = tid + 512 * i_; const int kv_ = id_ & 63, ch_ = id_ >> 6, kp_ = 64 * (kt) + kv_; \
        vreg[i_] = *(const GAS u32x4*)(a.V + (size_t)ATOK(a.k_tok0, kp_) * a.kv_pitch + ch_ * 8); } } while (0)
#define STORE_K(buf) do { _Pragma("unroll") for (int i_ = 0; i_ < 2; ++i_) { const int id_ = tid + 512 * i_; const int row_ = id_ >> 4, ch_ = id_ & 15; \
        *(LAS u32x4*)(lds + OFF_K + (buf) * KBUF + row_ * KROW + ch_ * 16) = kreg[i_]; } } while (0)
#define STORE_V(buf) do { _Pragma("unroll") for (int i_ = 0; i_ < 2; ++i_) { const int id_ = tid + 512 * i_; const int kv_ = id_ & 63, ch_ = id_ >> 6; \
        const int pos_ = (kv_ & ~15) | (kv_ & 3) | ((kv_ & 4) << 1) | ((kv_ & 8) >> 1); \
        LAS unsigned short* vp_ = (LAS unsigned short*)(lds + OFF_V + (buf) * VBUF + (8 * ch_) * VROW + pos_ * 2); \
        _Pragma("unroll") for (int e_ = 0; e_ < 8; ++e_) vp_[e_ * (VROW / 2)] = (unsigned short)(vreg[i_][e_ >> 1] >> (16 * (e_ & 1))); } } while (0)
    constexpr bool REV = (MODE == 1);
    const int ntile = a.kt_hi - a.kt_lo;
    const bool late = wid >= 4;
#define KT_OF(it_) (REV ? a.kt_hi - 1 - (it_) : a.kt_lo + (it_))
#define SKIP_OF(kt_, sk_, nm_) do { const int kl_ = 64 * (kt_); sk_ = false; nm_ = false; \
        if (MODE == 1) { sk_ = kl_ > qlo + 31; nm_ = kl_ + 63 > qlo; } \
        if (MODE == 2) { sk_ = (kl_ > qlo + 31) || (kl_ + 63 < qlo - 128) || ((kl_ >> a.logL) != (qlo >> a.logL)); nm_ = true; } } while (0)
    LOAD_K(KT_OF(0)); LOAD_V(KT_OF(0)); STORE_K(0); STORE_V(0);
    if (ntile > 1) { LOAD_K(KT_OF(1)); STORE_K(1); LOAD_V(KT_OF(1)); }
    if (ntile > 2) LOAD_K(KT_OF(2));
    __syncthreads();
    f32x16 s0, s1;
    if (late) { bool sk, nm; SKIP_OF(KT_OF(0), sk, nm); (void)nm; if (!sk) att_qk(lds, 0, qf, s0, s1, r32, hi); }
    int kb3 = 0;
    for (int it = 0; it < ntile; ++it) {
        const int kt = KT_OF(it), kb3n = kb3 == 2 ? 0 : kb3 + 1, kb3nn = kb3n == 2 ? 0 : kb3n + 1;
        bool sk, nm; SKIP_OF(kt, sk, nm);
        if (!late && !sk) att_qk(lds, kb3, qf, s0, s1, r32, hi);
        if (!sk) att_smpv<MODE>(lds, it & 1, 64 * kt, nm, s0, s1, o, mrun, lrun, bl, qp, r32, hi);
        if (late && it + 1 < ntile) { bool sk1, nm1; SKIP_OF(KT_OF(it + 1), sk1, nm1); (void)nm1; if (!sk1) att_qk(lds, kb3n, qf, s0, s1, r32, hi); }
        if (it + 1 < ntile) STORE_V((it + 1) & 1);
        if (it + 2 < ntile) STORE_K(kb3nn);
        if (it + 3 < ntile) LOAD_K(KT_OF(it + 3));
        if (it + 2 < ntile) LOAD_V(KT_OF(it + 2));
        __syncthreads();
        kb3 = kb3n;
    }
#undef LOAD_K
#undef LOAD_V
#undef STORE_K
#undef STORE_V
#undef KT_OF
#undef SKIP_OF
    lrun += __shfl_xor(lrun, 32);
    const float inv = 1.0f / lrun;
    bf16_t* orow = a.O + qtok * a.o_pitch;
#pragma unroll
    for (int db = 0; db < 4; ++db)
#pragma unroll
        for (int g4 = 0; g4 < 4; ++g4) { u32x2 w; w.x = cvt_pk_bf16(o[db][4 * g4] * inv, o[db][4 * g4 + 1] * inv); w.y = cvt_pk_bf16(o[db][4 * g4 + 2] * inv, o[db][4 * g4 + 3] * inv);
            *(GAS u32x2*)(orow + 32 * db + 8 * g4 + 4 * hi) = w; }
    if (MODE == 2) { if (hi == 0) ((GAS float*)a.lse)[qtok * a.lse_pitch] = (mrun + log2f(lrun)) * LN2; }
#undef ATOK
}
}


__device__ __forceinline__ unsigned xb_xcc_id() { return (unsigned)__builtin_amdgcn_s_getreg((3 << 11) | 20) & 0xFu; }
__device__ __forceinline__ void group_barrier(unsigned* cnt, unsigned n, int wb) {
    asm volatile("s_waitcnt vmcnt(0)" ::: "memory");
    __syncthreads();
    if (threadIdx.x == 0) {
        if (wb) { __builtin_amdgcn_fence(__ATOMIC_RELEASE, "agent"); asm volatile("s_waitcnt vmcnt(0)" ::: "memory"); }
        const unsigned old = __hip_atomic_fetch_add(cnt, 1u, __ATOMIC_RELAXED, __HIP_MEMORY_SCOPE_AGENT);
        const unsigned target = (old / n + 1u) * n;
        unsigned sp = 0u;
        while (__hip_atomic_load(cnt, __ATOMIC_RELAXED, __HIP_MEMORY_SCOPE_AGENT) < target) { __builtin_amdgcn_s_sleep(1); if (++sp > (1u << 26)) break; }
        __builtin_amdgcn_fence(__ATOMIC_ACQUIRE, "agent");
        asm volatile("s_waitcnt vmcnt(0)" ::: "memory");
    }
    __syncthreads();
}
struct Topo {
    unsigned* xcnt; unsigned* pcnt; unsigned nx, np; int wb, fast;
    int b0, NB, nloc, k;
    int pm, member;
};

__device__ __forceinline__ int dest_row(int kind, int n) { if (kind == 0) return n; const int half = n >= DFF ? 1 : 0, c = n - half * DFF; return 256 * (c >> 7) + 128 * half + (c & 127); }
__device__ __forceinline__ void transpose_item(const float* W, int K, int N, bf16_t* WT, int kind, const float* gfold, LAS float* scr, int item, int lane) {
    const int nblk = (N + 31) / 32, kb = item / nblk, nb = item % nblk, k0 = 64 * kb, n0 = 32 * nb;
    const int nn = n0 + 4 * (lane & 7); const bool ok = nn < N;
    f32x4 v[8];
#pragma unroll
    for (int i = 0; i < 8; ++i) { const int kk = 8 * i + (lane >> 3); v[i] = ok ? __builtin_nontemporal_load((const GAS f32x4*)(W + (size_t)(k0 + kk) * N + nn)) : (f32x4){0.f, 0.f, 0.f, 0.f}; }
    if (gfold) {
#pragma unroll
        for (int i = 0; i < 8; ++i) v[i] = v[i] * ((const GAS float*)gfold)[k0 + 8 * i + (lane >> 3)];
    }
#pragma unroll
    for (int i = 0; i < 8; ++i) { LAS float* d = scr + (8 * i + (lane >> 3)) * 33 + 4 * (lane & 7); d[0] = v[i].x; d[1] = v[i].y; d[2] = v[i].z; d[3] = v[i].w; }
    asm volatile("s_waitcnt lgkmcnt(0)" ::: "memory");
    const int c = lane & 7;
#pragma unroll
    for (int j = 0; j < 4; ++j) { const int n = (lane >> 3) + 8 * j; const LAS float* s = scr + (8 * c) * 33 + n;
        u32x4 o; o.x = cvt_pk_bf16(s[0 * 33], s[1 * 33]); o.y = cvt_pk_bf16(s[2 * 33], s[3 * 33]); o.z = cvt_pk_bf16(s[4 * 33], s[5 * 33]); o.w = cvt_pk_bf16(s[6 * 33], s[7 * 33]);
        *(GAS u32x4*)(WT + (size_t)dest_row(kind, n0 + n) * K + k0 + 8 * c) = o; }
    asm volatile("s_waitcnt lgkmcnt(0)" ::: "memory");
}
__device__ __forceinline__ void convert_matrix(const float* W, int K, int N, bf16_t* WT, int kind, const float* gfold, LAS float* scr, int gw, int ngw, int lane) {
    asm volatile("" : "+v"(lane));
    const int nitems = (K / 64) * ((N + 31) / 32);
    for (int it = gw; it < nitems; it += ngw) transpose_item(W, K, N, WT, kind, gfold, scr, it, lane);
}
__device__ __forceinline__ void gate_mini(const bf16_t* xb, const float* P, const bf16_t* Wg, float* gate, int row0, int tid) {
    asm volatile("" : "+v"(tid));
    const int lane = tid & 63, wid = __builtin_amdgcn_readfirstlane(tid >> 6);
    if (wid >= 4) return;
    const int r = lane & 15, kq = lane >> 4, row = row0 + 16 * wid + r;
    const bf16_t* ap = xb + (size_t)row * DM + 8 * kq;
    const bf16_t* bp = Wg + (size_t)r * DM + 8 * kq;
    f32x4 acc = {0.f, 0.f, 0.f, 0.f};
#pragma unroll 8
    for (int kk = 0; kk < 64; ++kk) {
        const bf16x8 a = *(const GAS bf16x8*)(ap + 32 * kk), b = *(const GAS bf16x8*)(bp + 32 * kk);
        acc = __builtin_amdgcn_mfma_f32_16x16x32_bf16(a, b, acc, 0, 0, 0);
    }
    const float* pp = P + (size_t)row * 32 + 8 * kq;
    const f32x4 p0 = *(const GAS f32x4*)pp, p1 = *(const GAS f32x4*)(pp + 4);
    float s = ((p0.x + p0.y) + (p0.z + p0.w)) + ((p1.x + p1.y) + (p1.z + p1.w)); s += __shfl_xor(s, 16); s += __shfl_xor(s, 32);
    const float rs = __builtin_amdgcn_rsqf(s * (1.0f / DM) + RMS_EPS);
#pragma unroll
    for (int j = 0; j < 4; ++j) { const float rr = __shfl(rs, 4 * kq + j); ((GAS float*)gate)[(size_t)(row0 + 16 * wid + 4 * kq + j) * 16 + r] = acc[j] * rr; }
}
__device__ __forceinline__ void rows_to_xb(const float* x, bf16_t* xb, float* P, int nrows, int gw, int ngw, int lane) {
    asm volatile("" : "+v"(lane));
    for (int m = gw; m < nrows; m += ngw) {
        const float* xr = x + (size_t)m * DM + 4 * lane; f32x4 v[8]; float s = 0.f;
#pragma unroll
        for (int j = 0; j < 8; ++j) { v[j] = *(const GAS f32x4*)(xr + 256 * j); s += (v[j].x * v[j].x + v[j].y * v[j].y) + (v[j].z * v[j].z + v[j].w * v[j].w); }
        s = wave_sum(s);
        bf16_t* orow = xb + (size_t)m * DM + 4 * lane;
#pragma unroll
        for (int j = 0; j < 8; ++j) { u32x2 w; w.x = cvt_pk_bf16(v[j].x, v[j].y); w.y = cvt_pk_bf16(v[j].z, v[j].w); *(GAS u32x2*)(orow + 256 * j) = w; }
        if (lane < 32) ((GAS float*)P)[(size_t)m * 32 + lane] = lane == 0 ? s : 0.f;
    }
}
__device__ __forceinline__ void rms_rows_bf16(const float* x, const float* g, bf16_t* out, int out_pitch, int nrows, int gw, int ngw, int lane) {
    asm volatile("" : "+v"(lane));
    f32x4 gg[8];
#pragma unroll
    for (int j = 0; j < 8; ++j) gg[j] = *(const GAS f32x4*)(g + 4 * lane + 256 * j);
    for (int m = gw; m < nrows; m += ngw) {
        const float* xr = x + (size_t)m * DM + 4 * lane; f32x4 v[8]; float s = 0.f;
#pragma unroll
        for (int j = 0; j < 8; ++j) { v[j] = *(const GAS f32x4*)(xr + 256 * j); s += (v[j].x * v[j].x + v[j].y * v[j].y) + (v[j].z * v[j].z + v[j].w * v[j].w); }
        const float rstd = 1.0f / sqrtf(wave_sum(s) * (1.0f / DM) + RMS_EPS);
        bf16_t* orow = out + (size_t)m * out_pitch + 4 * lane;
#pragma unroll
        for (int j = 0; j < 8; ++j) { u32x2 w; w.x = cvt_pk_bf16(v[j].x * rstd * gg[j].x, v[j].y * rstd * gg[j].y); w.y = cvt_pk_bf16(v[j].z * rstd * gg[j].z, v[j].w * rstd * gg[j].w); *(GAS u32x2*)(orow + 256 * j) = w; }
    }
}
__device__ __forceinline__ void rms_rows_f32_inplace(float* x, const float* g, int nrows, int gw, int ngw, int lane) {
    asm volatile("" : "+v"(lane));
    f32x4 gg[8];
#pragma unroll
    for (int j = 0; j < 8; ++j) gg[j] = *(const GAS f32x4*)(g + 4 * lane + 256 * j);
    for (int m = gw; m < nrows; m += ngw) {
        float* xr = x + (size_t)m * DM + 4 * lane; f32x4 v[8]; float s = 0.f;
#pragma unroll
        for (int j = 0; j < 8; ++j) { v[j] = *(const GAS f32x4*)(xr + 256 * j); s += (v[j].x * v[j].x + v[j].y * v[j].y) + (v[j].z * v[j].z + v[j].w * v[j].w); }
        const float rstd = 1.0f / sqrtf(wave_sum(s) * (1.0f / DM) + RMS_EPS);
#pragma unroll
        for (int j = 0; j < 8; ++j) *(GAS f32x4*)(xr + 256 * j) = v[j] * rstd * gg[j];
    }
}

struct KArgs { const float* in[21]; float* out; unsigned char* ws; };
#define PHASE_BEGIN { unsigned char* ws = args.ws; asm volatile("" : "+s"(ws)); float* xr = args.out; asm volatile("" : "+s"(xr)); \
    bf16_t* HB = (bf16_t*)(ws + WS_HB); bf16_t* ACT = (bf16_t*)(ws + WS_ACT); bf16_t* CQ = (bf16_t*)(ws + WS_CQ); bf16_t* CO = (bf16_t*)(ws + WS_CO); \
    bf16_t* MEMN = (bf16_t*)(ws + WS_MEMN); bf16_t* KVB = (bf16_t*)(ws + WS_KV); float* GATE = (float*)(ws + WS_GATE); float* LSE = (float*)(ws + WS_LSE); bf16_t* XB = (bf16_t*)(ws + WS_XB); float* PP = (float*)(ws + WS_P); \
    (void)XB; (void)PP; (void)HB; (void)ACT; (void)CQ; (void)CO; (void)MEMN; (void)KVB; (void)GATE; (void)LSE; (void)xr;
#define SEAM_P      group_barrier(T.pcnt, T.np, T.wb); }
#define SEAM_X      group_barrier(T.xcnt, T.nx, T.wb); }
#define PHASE_END_LAST }

#define PH_PARAMS const KArgs& args, LAS unsigned char* lds, const Topo& T, const int G, const int bx, const int gw, const int ngw, const int lane, const int tid
#define PH_ARGS args, lds, T, G, bx, gw, ngw, lane, tid

template <int layer> __device__ __forceinline__ void mixer_phases(PH_PARAMS) {
                PHASE_BEGIN
                {
                    pg8::GemmSet g; g.A0 = XB; g.B0 = (const bf16_t*)(ws + (layer == 0 ? WS_FOX_IN : WS_DIL_IN)); g.A1 = MEMN; g.B1 = (const bf16_t*)(ws + WS_CKV_W + (size_t)layer * 4 * MiB); g.K = DM; g.lda = DM;
                    if (layer == 0) {
                        const bf16_t* Wg = (const bf16_t*)(ws + WS_FOX_IN) + (size_t)FOX_QKV * DM;
                        if (T.fast) gate_mini(XB, PP, Wg, GATE, 256 * T.pm + 64 * T.member, tid);
                        else for (int blk = bx; blk < TOK / 64; blk += G) gate_mini(XB, PP, Wg, GATE, 64 * blk, tid);
                    }
                    pg8::Order S; if (layer == 0) S.init(TOK, FOX_QKV, 0, 0, G, bx); else S.init(TOK, DIL_N, TMEM, CR_KV, G, bx);
                    pg8::EpiProj E; E.O0 = ACT; E.ld0 = ACT_LD; E.nscale = layer == 0 ? 8 : 9; E.scale0 = QSCALE; E.gate_tile = -1; E.gate = GATE; E.P = PP;
                    E.O1 = KVB + (size_t)layer * TMEM * CR_KV; E.ld1 = CR_KV;
                    pg8::gemm_phase<pg8::EpiProj>(lds, g, S, E);
                }
                SEAM_X
                PHASE_BEGIN
                if (layer == 0) {
                    for (int i = 0;; ++i) {
                        const int p = i * T.nloc + ((i & 1) ? (T.nloc - 1 - T.k) : T.k);
                        if (p >= T.NB * 128) break;
                        const int qb = 7 - p / (16 * T.NB), rest = p % (16 * T.NB), b = T.b0 + (rest >> 4), h = rest & 15;
                        att::Args a; a.Q = ACT + h * 128; a.K = ACT + 2048 + h * 128; a.V = ACT + 4096 + h * 128; a.O = HB + h * 128; a.lse = nullptr;
                        a.q_pitch = ACT_LD; a.kv_pitch = ACT_LD; a.o_pitch = HB_LD; a.lse_pitch = 0; a.q_tok0 = b * SEQ; a.k_tok0 = b * SEQ; a.dil = 1; a.logL = 20;
                        a.q0 = 256 * qb; a.kt_lo = 0; a.kt_hi = 4 * (qb + 1); a.aux = GATE + h; a.bf = ((const GAS float*)args.in[7])[h];
                        att::unit<1>(lds, a);
                    }
                } else {
                    for (int i = 0;; ++i) {
                        const int p = i * T.nloc + T.k;
                        if (p >= T.NB * 144) break;
                        const int grp = p / (48 * T.NB), rr = p % (48 * T.NB), b = T.b0 + rr / 48, r = rr % 48, gh = r >> 3, sub = r & 7;
                        int rho = 0, q0 = 0, dil, logL;
                        if (grp == 0) { dil = 1; logL = 11; q0 = 256 * sub; }
                        else if (grp == 1) { rho = sub >> 1; dil = 4; logL = 9; q0 = 256 * (sub & 1); }
                        else { rho = 2 * sub; dil = 16; logL = 7; q0 = 0; }
                        const int head = grp * 6 + gh;
                        att::Args a; a.Q = ACT + head * 128; a.K = ACT + DIL_HD + head * 128; a.V = ACT + 2 * DIL_HD + head * 128; a.O = HB + head * 128; a.lse = LSE + head;
                        a.q_pitch = ACT_LD; a.kv_pitch = ACT_LD; a.o_pitch = HB_LD; a.lse_pitch = DILH; a.q_tok0 = b * SEQ + rho; a.k_tok0 = b * SEQ + rho; a.dil = dil; a.logL = logL;
                        a.q0 = q0; a.kt_lo = (q0 >= 128 ? q0 - 128 : 0) >> 6; a.kt_hi = (q0 + 256) >> 6; a.aux = args.in[11] + head; a.bf = 0.f;
                        att::unit<2>(lds, a);
                    }
                }
                SEAM_X
                if (layer == 1) {
                    PHASE_BEGIN
                    int tid_l = tid; asm volatile("" : "+v"(tid_l));
                    const long i0 = T.fast ? (long)(256 * T.pm + 64 * T.member) * 288 + tid_l : (long)bx * 512 + tid_l;
                    const long i1 = T.fast ? (long)(256 * T.pm + 64 * T.member + 64) * 288 : (long)TOK * 288, istep = T.fast ? 512 : (long)G * 512;
                    for (long idx = i0; idx < i1; idx += istep) {
                        const int t = (int)(idx / 288), cc = (int)(idx % 288), head = cc >> 4, gh = head % 6, grp = head / 6;
                        const GAS float* lsg = (const GAS float*)LSE; const float l0 = lsg[(size_t)t * DILH + gh], l1 = lsg[(size_t)t * DILH + 6 + gh], l2 = lsg[(size_t)t * DILH + 12 + gh];
                        const float mx = fmaxf(l0, fmaxf(l1, l2)); const float e0 = expf(l0 - mx), e1 = expf(l1 - mx), e2 = expf(l2 - mx);
                        const float al = (grp == 0 ? e0 : (grp == 1 ? e1 : e2)) / (e0 + e1 + e2);
                        GAS u32x4* p = (GAS u32x4*)(HB + (size_t)t * DIL_HD + cc * 8); u32x4 v = *p;
                        v.x = cvt_pk_bf16(bf_lo(v.x) * al, bf_hi(v.x) * al); v.y = cvt_pk_bf16(bf_lo(v.y) * al, bf_hi(v.y) * al); v.z = cvt_pk_bf16(bf_lo(v.z) * al, bf_hi(v.z) * al); v.w = cvt_pk_bf16(bf_lo(v.w) * al, bf_hi(v.w) * al);
                        *p = v;
                    }
                    SEAM_P
                }
                PHASE_BEGIN
                {
                    pg8::GemmSet g; g.A0 = HB; g.B0 = (const bf16_t*)(ws + (layer == 0 ? WS_FOX_OUT : WS_DIL_OUT)); g.A1 = nullptr; g.B1 = nullptr; g.K = layer == 0 ? DM : DIL_HD; g.lda = HB_LD;
                    pg8::Order S; S.init(TOK, DM, 0, 0, G, bx);
                    pg8::EpiResid E; E.base32 = nullptr; E.xb = XB; E.out32 = nullptr; E.alpha = 1.0f; E.P = PP;
                    pg8::gemm_phase<pg8::EpiResid>(lds, g, S, E);
                }
                SEAM_P
                PHASE_BEGIN
                {
                    pg8::GemmSet g; g.A0 = XB; g.B0 = (const bf16_t*)(ws + WS_CQ_W + (size_t)layer * 2 * MiB); g.A1 = MEMN; g.B1 = (const bf16_t*)(ws + WS_CKV_W); g.K = DM; g.lda = DM;
                    pg8::Order S; if (layer == 0) S.init(TOK, CR_HD, TMEM, CR_KV, G, bx); else S.init(TOK, CR_HD, 0, 0, G, bx);
                    pg8::EpiProj E; E.O0 = CQ; E.ld0 = CR_HD; E.nscale = 2; E.scale0 = QSCALE; E.gate_tile = -1; E.gate = nullptr; E.O1 = KVB; E.ld1 = CR_KV; E.P = PP;
                    pg8::gemm_phase<pg8::EpiProj>(lds, g, S, E);
                }
                if (layer == 0) group_barrier(T.xcnt, T.nx, T.wb); else group_barrier(T.pcnt, T.np, T.wb); }
                PHASE_BEGIN
                for (int i = 0;; ++i) {
                    const int p = i * T.nloc + T.k;
                    if (p >= T.NB * 32) break;
                    const int qb = p & 7, h = (p >> 3) & 3, b = T.b0 + (p >> 5);
                    const bf16_t* kv = KVB + (size_t)layer * TMEM * CR_KV;
                    att::Args a; a.Q = CQ + h * 128; a.K = kv + h * 128; a.V = kv + CR_HD + h * 128; a.O = CO + h * 128; a.lse = nullptr;
                    a.q_pitch = CR_HD; a.kv_pitch = CR_KV; a.o_pitch = CR_HD; a.lse_pitch = 0; a.q_tok0 = b * SEQ; a.k_tok0 = b * NMEM; a.dil = 1; a.logL = 20;
                    a.q0 = 256 * qb; a.kt_lo = 0; a.kt_hi = 4; a.aux = nullptr; a.bf = 0.f;
                    att::unit<0>(lds, a);
                }
                SEAM_P
                PHASE_BEGIN
                {
                    pg8::GemmSet g; g.A0 = CO; g.B0 = (const bf16_t*)(ws + WS_CO_W + (size_t)layer * 2 * MiB); g.A1 = nullptr; g.B1 = nullptr; g.K = CR_HD; g.lda = CR_HD;
                    pg8::Order S; S.init(TOK, DM, 0, 0, G, bx);
                    pg8::EpiResid E; E.base32 = nullptr; E.xb = XB; E.out32 = nullptr; E.alpha = 1.0f; E.P = PP;
                    pg8::gemm_phase<pg8::EpiResid>(lds, g, S, E);
                }
                SEAM_P
}
template <int layer, int f> __device__ __forceinline__ void ffn_phases(PH_PARAMS) {
            PHASE_BEGIN
            {
                pg8::GemmSet g; g.A0 = XB; g.B0 = (const bf16_t*)(ws + WS_FFN_IN + (size_t)(2 * layer + f) * SZ_FFN_IN); g.A1 = nullptr; g.B1 = nullptr; g.K = DM; g.lda = DM;
                pg8::Order S; S.init(TOK, 2 * DFF, 0, 0, G, bx);
                pg8::EpiSwiglu E; E.O = ACT; E.P = PP;
                pg8::gemm_phase<pg8::EpiSwiglu>(lds, g, S, E);
            }
            SEAM_P
            PHASE_BEGIN
            {
                pg8::GemmSet g; g.A0 = ACT; g.B0 = (const bf16_t*)(ws + WS_FFN_OUT + (size_t)(2 * layer + f) * SZ_FFN_OUT); g.A1 = nullptr; g.B1 = nullptr; g.K = DFF; g.lda = ACT_LD;
                pg8::Order S; S.init(TOK, DM, 0, 0, G, bx);
                pg8::EpiResid E; E.base32 = (layer == 0 && f == 0) ? args.in[0] : nullptr; E.xb = XB; E.out32 = (layer == 1 && f == 1) ? xr : nullptr; E.alpha = 0.5f; E.P = PP;
                pg8::gemm_phase<pg8::EpiResid>(lds, g, S, E);
            }
            SEAM_P
}

__global__ void __launch_bounds__(512, 2) fwd_megakernel(KArgs args) {
    extern __shared__ __attribute__((aligned(16))) unsigned char lds_raw[];
    LAS unsigned char* lds = (LAS unsigned char*)lds_raw;
    cg::grid_group grid = cg::this_grid();
    const int tid = threadIdx.x, lane = tid & 63, wave = __builtin_amdgcn_readfirstlane(tid >> 6);
    const int G = gridDim.x, bx = blockIdx.x;
    const int gw = bx * 8 + wave, ngw = G * 8;
    unsigned* ctl = (unsigned*)(args.ws + WS_BAR);
    if (bx == 0) for (int i = tid; i < 8192; i += 512) __hip_atomic_store(ctl + i, 0u, __ATOMIC_RELAXED, __HIP_MEMORY_SCOPE_AGENT);
    if (tid == 0) __hip_atomic_store(ctl + 8192 + bx, xb_xcc_id() + 1u, __ATOMIC_RELAXED, __HIP_MEMORY_SCOPE_AGENT);
    PHASE_BEGIN
    {
        LAS float* scr = (LAS float*)(lds + wave * 16384);
        convert_matrix(args.in[19] + (size_t)DFF * DM, DFF, DM, (bf16_t*)(ws + WS_FFN_OUT + (size_t)3 * SZ_FFN_OUT), 0, nullptr, scr, gw, ngw, lane);
        convert_matrix(args.in[18] + (size_t)DM * 2 * DFF, DM, 2 * DFF, (bf16_t*)(ws + WS_FFN_IN + (size_t)3 * SZ_FFN_IN), 1, args.in[17] + DM, scr, gw, ngw, lane);
        convert_matrix(args.in[16] + (size_t)CR_HD * DM, CR_HD, DM, (bf16_t*)(ws + WS_CO_W + (size_t)2 * MiB), 0, nullptr, scr, gw, ngw, lane);
        convert_matrix(args.in[14] + (size_t)DM * CR_HD, DM, CR_HD, (bf16_t*)(ws + WS_CQ_W + (size_t)2 * MiB), 0, args.in[12] + DM, scr, gw, ngw, lane);
        convert_matrix(args.in[10], DIL_HD, DM, (bf16_t*)(ws + WS_DIL_OUT), 0, nullptr, scr, gw, ngw, lane);
        convert_matrix(args.in[15] + (size_t)DM * CR_KV, DM, CR_KV, (bf16_t*)(ws + WS_CKV_W + (size_t)4 * MiB), 0, nullptr, scr, gw, ngw, lane);
        convert_matrix(args.in[9], DM, DIL_N, (bf16_t*)(ws + WS_DIL_IN), 0, args.in[5] + DM, scr, gw, ngw, lane);
        convert_matrix(args.in[4] + (size_t)DFF * DM, DFF, DM, (bf16_t*)(ws + WS_FFN_OUT + (size_t)2 * SZ_FFN_OUT), 0, nullptr, scr, gw, ngw, lane);
        convert_matrix(args.in[3] + (size_t)DM * 2 * DFF, DM, 2 * DFF, (bf16_t*)(ws + WS_FFN_IN + (size_t)2 * SZ_FFN_IN), 1, args.in[2] + DM, scr, gw, ngw, lane);
        convert_matrix(args.in[19], DFF, DM, (bf16_t*)(ws + WS_FFN_OUT + (size_t)1 * SZ_FFN_OUT), 0, nullptr, scr, gw, ngw, lane);
        convert_matrix(args.in[18], DM, 2 * DFF, (bf16_t*)(ws + WS_FFN_IN + (size_t)1 * SZ_FFN_IN), 1, args.in[17], scr, gw, ngw, lane);
        convert_matrix(args.in[16], CR_HD, DM, (bf16_t*)(ws + WS_CO_W), 0, nullptr, scr, gw, ngw, lane);
        convert_matrix(args.in[15], DM, CR_KV, (bf16_t*)(ws + WS_CKV_W), 0, nullptr, scr, gw, ngw, lane);
        convert_matrix(args.in[14], DM, CR_HD, (bf16_t*)(ws + WS_CQ_W), 0, args.in[12], scr, gw, ngw, lane);
        convert_matrix(args.in[8], DM, DM, (bf16_t*)(ws + WS_FOX_OUT), 0, nullptr, scr, gw, ngw, lane);
        convert_matrix(args.in[6], DM, FOX_N, (bf16_t*)(ws + WS_FOX_IN), 0, args.in[5], scr, gw, ngw, lane);
        convert_matrix(args.in[4], DFF, DM, (bf16_t*)(ws + WS_FFN_OUT), 0, nullptr, scr, gw, ngw, lane);
        convert_matrix(args.in[3], DM, 2 * DFF, (bf16_t*)(ws + WS_FFN_IN), 1, args.in[2], scr, gw, ngw, lane);
        rms_rows_bf16(args.in[1], args.in[13], MEMN, DM, TMEM, gw, ngw, lane);
        rows_to_xb(args.in[0], XB, PP, TOK, gw, ngw, lane);
    }
    grid.sync(); }
    Topo T;
    T.fast = (G == 256);
    if (T.fast) {
        const int xcd = bx & 7, kk = bx >> 3;
        T.b0 = xcd; T.NB = 1; T.nloc = 32; T.k = kk; T.pm = 8 * xcd + (kk & 7); T.member = kk >> 3;
        T.xcnt = ctl + 64 * xcd; T.pcnt = ctl + 64 * (8 + T.pm); T.nx = 32u; T.np = 4u;
        const unsigned mine = __hip_atomic_load(ctl + 8192 + bx, __ATOMIC_RELAXED, __HIP_MEMORY_SCOPE_AGENT); int same = 1;
        for (int j = 0; j < 32; ++j) same &= (__hip_atomic_load(ctl + 8192 + xcd + 8 * j, __ATOMIC_RELAXED, __HIP_MEMORY_SCOPE_AGENT) == mine) ? 1 : 0;
        T.wb = __builtin_amdgcn_readfirstlane(same) ? 0 : 1;
    } else {
        T.b0 = 0; T.NB = 8; T.nloc = G; T.k = bx; T.pm = 0; T.member = 0;
        T.xcnt = ctl + 64 * 100; T.pcnt = T.xcnt; T.nx = (unsigned)G; T.np = (unsigned)G; T.wb = 1;
    }
    ffn_phases<0, 0>(PH_ARGS);
    mixer_phases<0>(PH_ARGS);
    ffn_phases<0, 1>(PH_ARGS);
    ffn_phases<1, 0>(PH_ARGS);
    mixer_phases<1>(PH_ARGS);
    ffn_phases<1, 1>(PH_ARGS);
    PHASE_BEGIN
    if (T.fast) rms_rows_f32_inplace(xr + (size_t)(256 * T.pm + 64 * T.member) * DM, args.in[20], 64, wave, 8, lane);
    else rms_rows_f32_inplace(xr, args.in[20], TOK, gw, ngw, lane);
    PHASE_END_LAST
}

extern "C" void kernel_launch(void* const* d_in, const int* in_sizes, int n_in, void* d_out, int out_size, void* d_ws, size_t ws_size, hipStream_t stream) {
    static int grid = 0;
    if (grid == 0) {
        if (n_in != 21 || out_size != TOK * DM || ws_size < WS_END) { fprintf(stderr, "kernel_launch: unexpected problem (n_in %d out %d ws %zu need %zu)\n", n_in, out_size, ws_size, (size_t)WS_END); grid = -1; return; }
        int dev = 0, cus = 0, per_cu = 0;
        if (hipGetDevice(&dev) != hipSuccess || hipDeviceGetAttribute(&cus, hipDeviceAttributeMultiprocessorCount, dev) != hipSuccess) { grid = -1; return; }
        if (hipFuncSetAttribute((const void*)fwd_megakernel, hipFuncAttributeMaxDynamicSharedMemorySize, LDS_BYTES) != hipSuccess) { fprintf(stderr, "kernel_launch: hipFuncSetAttribute failed\n"); grid = -1; return; }
        if (hipOccupancyMaxActiveBlocksPerMultiprocessor(&per_cu, (const void*)fwd_megakernel, 512, LDS_BYTES) != hipSuccess || per_cu < 1) { fprintf(stderr, "kernel_launch: occupancy query says %d\n", per_cu); per_cu = 1; }
        (void)hipGetLastError();
        grid = cus * per_cu;
    }
    if (grid < 0) return;
    KArgs a{};
    for (int i = 0; i < 21; ++i) a.in[i] = (const float*)d_in[i];
    a.out = (float*)d_out; a.ws = (unsigned char*)d_ws;
    void* kargs[] = {&a};
    hipError_t e = hipLaunchCooperativeKernel((const void*)fwd_megakernel, dim3(grid), dim3(512), kargs, LDS_BYTES, stream);
    if (e != hipSuccess) fprintf(stderr, "kernel_launch: cooperative launch failed: %s (grid %d)\n", hipGetErrorString(e), grid);
}
```

```cpp
#include <hip/hip_runtime.h>
#include <hip/hip_cooperative_groups.h>
#include <cstdio>
#include <cstdint>
namespace cg = cooperative_groups;

#define LAS __attribute__((address_space(3)))
#define GAS __attribute__((address_space(1)))
typedef unsigned short bf16_t;
typedef short bf16x8 __attribute__((ext_vector_type(8)));
typedef float f32x4 __attribute__((ext_vector_type(4)));
typedef float f32x16 __attribute__((ext_vector_type(16)));
typedef unsigned u32x4 __attribute__((ext_vector_type(4)));
typedef unsigned u32x2 __attribute__((ext_vector_type(2)));

constexpr int BATCH = 8, SEQ = 2048, DM = 2048, TOK = BATCH * SEQ, NMEM = 256, TMEM = BATCH * NMEM;
constexpr int FOXH = 16, DILH = 18, CRH = 4, DFF = 5632;
constexpr int FOX_N = 6160, FOX_QKV = 6144, DIL_N = 6912, DIL_HD = 2304, CR_HD = 512, CR_KV = 1024;
constexpr int ACT_LD = 6912, HB_LD = 2304;
constexpr float LOG2E = 1.4426950408889634f, LN2 = 0.6931471805599453f;
constexpr float QSCALE = 0.08838834764831845f * 1.4426950408889634f;
constexpr float RMS_EPS = 1e-6f;

constexpr size_t MiB = 1u << 20;
constexpr size_t SZ_FFN_IN = 44 * MiB, SZ_FFN_OUT = 22 * MiB;
constexpr size_t WS_FFN_IN = 0;
constexpr size_t WS_FFN_OUT = WS_FFN_IN + 4 * SZ_FFN_IN;
constexpr size_t WS_FOX_IN = WS_FFN_OUT + 4 * SZ_FFN_OUT;
constexpr size_t WS_FOX_OUT = WS_FOX_IN + 25 * MiB;
constexpr size_t WS_DIL_IN = WS_FOX_OUT + 8 * MiB;
constexpr size_t WS_DIL_OUT = WS_DIL_IN + 27 * MiB;
constexpr size_t WS_CQ_W = WS_DIL_OUT + 9 * MiB;
constexpr size_t WS_CKV_W = WS_CQ_W + 4 * MiB;
constexpr size_t WS_CO_W = WS_CKV_W + 8 * MiB;
constexpr size_t WS_MEMN = WS_CO_W + 4 * MiB;
constexpr size_t WS_KV = WS_MEMN + 8 * MiB;
constexpr size_t WS_HB = WS_KV + 8 * MiB;
constexpr size_t WS_ACT = WS_HB + 72 * MiB;
constexpr size_t WS_CQ = WS_ACT + 216 * MiB;
constexpr size_t WS_CO = WS_CQ + 16 * MiB;
constexpr size_t WS_GATE = WS_CO + 16 * MiB;
constexpr size_t WS_LSE = WS_GATE + 1 * MiB;
constexpr size_t WS_XB = WS_LSE + 2 * MiB;
constexpr size_t WS_P = WS_XB + 64 * MiB;
constexpr size_t WS_BAR = WS_P + 2 * MiB;
constexpr size_t WS_END = WS_BAR + 1 * MiB;

constexpr int LDS_BYTES = 149504;

__device__ __forceinline__ unsigned cvt_pk_bf16(float lo, float hi) {
    typedef float f2 __attribute__((ext_vector_type(2))); typedef __bf16 b2 __attribute__((ext_vector_type(2)));
    f2 v = {lo, hi}; b2 b = __builtin_convertvector(v, b2); return __builtin_bit_cast(unsigned, b);
}
__device__ __forceinline__ float bf_lo(unsigned w) { return __uint_as_float(w << 16); }
__device__ __forceinline__ float bf_hi(unsigned w) { return __uint_as_float(w & 0xffff0000u); }
__device__ __forceinline__ float wave_sum(float v) {
#pragma unroll
    for (int o = 1; o < 64; o <<= 1) v += __shfl_xor(v, o);
    return v;
}

namespace pg8 {
constexpr int BM = 256, BK = 64, HALF = 128, HTB = HALF * BK * 2, STAGE_BYTES = 8 * HTB, NXCD = 8, WGM = 8;
__device__ __forceinline__ int lds_byte(int r, int c) { const int st = (r >> 4) * 2 + (c >> 5), rr = r & 15, cc = c & 31, ob = rr * 64 + cc * 2; return st * 1024 + (ob ^ (((ob >> 9) & 1) << 5)); }
__device__ __forceinline__ void stage_rc(int b, int& R, int& C) { const int st = b / 1024, sb = b % 1024, swz = sb ^ (((sb >> 9) & 1) << 5); R = (st >> 1) * 16 + swz / 64; C = (st & 1) * 32 + (swz % 64) / 2; }
__device__ __forceinline__ int perm32(int rho) { const int n = rho >> 4, i = rho & 15; return 8 * (i >> 2) + 4 * n + (i & 3); }

struct Unit { int pm, pn, g; };
struct GemmSet { const bf16_t* A0; const bf16_t* B0; const bf16_t* A1; const bf16_t* B1; int K; int lda; };

struct Order {
    int nM0, nN0, nwg0, nM1, nwg1, G, c;
    __device__ void init(int M0, int N0, int M1, int N1, int G_, int c_) { nM0 = M0 / BM; nN0 = N0 / BM; nwg0 = nM0 * nN0; nM1 = M1 / BM; nwg1 = nM1 * (N1 / BM); G = G_; c = c_; }
    __device__ bool next(int i, Unit& u) const {
        long L = (long)i * G + c;
        if (L < nwg0) {
            int wgid = (int)L; { const int q = nwg0 / NXCD, r = nwg0 % NXCD, xcd = wgid % NXCD, off = wgid / NXCD; wgid = (xcd < r ? xcd * (q + 1) : r * (q + 1) + (xcd - r) * q) + off; }
            const int nig = WGM * nN0, gid = wgid / nig, fm = gid * WGM, gsz = (nM0 - fm) < WGM ? (nM0 - fm) : WGM;
            u.pm = fm + ((wgid % nig) % gsz); u.pn = (wgid % nig) / gsz; u.g = 0; return true;
        }
        L -= nwg0;
        if (L < nwg1) { u.pm = (int)(L % nM1); u.pn = (int)(L / nM1); u.g = 1; return true; }
        return false;
    }
};

__device__ __forceinline__ float silu_f(float x) { return x * __builtin_amdgcn_rcpf(1.0f + __builtin_amdgcn_exp2f(-LOG2E * x)); }

__device__ __forceinline__ void row_rstd(const float* P, int pm, int row0, int fq, int lane, LAS float* cache, int& tag, float (&rs)[2][4]) {
    if (!P) {
#pragma unroll
        for (int ai = 0; ai < 2; ++ai)
#pragma unroll
            for (int m = 0; m < 4; ++m) rs[ai][m] = 1.0f;
        return;
    }
    if (tag != pm) {
        tag = pm;
#pragma unroll
        for (int ai = 0; ai < 2; ++ai)
#pragma unroll
            for (int m = 0; m < 4; ++m) {
                const float* pp = P + (size_t)(row0 + ai * HALF + m * 16) * 32 + fq * 8; const f32x4 a = *(const GAS f32x4*)pp, b = *(const GAS f32x4*)(pp + 4);
                float s = ((a.x + a.y) + (a.z + a.w)) + ((b.x + b.y) + (b.z + b.w)); s += __shfl_xor(s, 16); s += __shfl_xor(s, 32);
                rs[ai][m] = __builtin_amdgcn_rsqf(s * (1.0f / DM) + RMS_EPS);
                cache[(ai * 4 + m) * 64 + lane] = rs[ai][m];
            }
    } else {
#pragma unroll
        for (int ai = 0; ai < 2; ++ai)
#pragma unroll
            for (int m = 0; m < 4; ++m) rs[ai][m] = cache[(ai * 4 + m) * 64 + lane];
    }
}
struct EpiSwiglu {
    static constexpr bool PERM = true;
    bf16_t* O; const float* P;
    __device__ __forceinline__ void operator()(const f32x4 (&acc)[2][2][4][2], const Unit& u, int wr, int wc, int fr, int fq, LAS float* cache, int& tag) const {
        const int row0 = u.pm * BM + wr * 64 + fr, col0 = u.pn * 128 + wc * 32 + 8 * fq;
        float rs[2][4]; row_rstd(P, u.pm, row0, fq, fr + 16 * fq, cache, tag, rs);
#pragma unroll
        for (int ai = 0; ai < 2; ++ai)
#pragma unroll
            for (int m = 0; m < 4; ++m) {
                bf16_t* rowp = O + (size_t)(row0 + ai * HALF + m * 16) * ACT_LD + col0; const float r = rs[ai][m];
                const float nrl = -LOG2E * r, r2 = r * r;
                const f32x4 ga = acc[ai][0][m][0], gb = acc[ai][0][m][1];
                const f32x4 pa = (ga * acc[ai][1][m][0]) * r2, pb = (gb * acc[ai][1][m][1]) * r2;
                const f32x4 ta = ga * nrl, tb = gb * nrl;
                f32x4 da, db;
#pragma unroll
                for (int j = 0; j < 4; ++j) { da[j] = __builtin_amdgcn_exp2f(ta[j]); db[j] = __builtin_amdgcn_exp2f(tb[j]); }
                da = da + 1.0f; db = db + 1.0f;
#pragma unroll
                for (int j = 0; j < 4; ++j) { da[j] = __builtin_amdgcn_rcpf(da[j]); db[j] = __builtin_amdgcn_rcpf(db[j]); }
                const f32x4 oa = pa * da, ob = pb * db;
                u32x4 w; w.x = cvt_pk_bf16(oa[0], oa[1]); w.y = cvt_pk_bf16(oa[2], oa[3]); w.z = cvt_pk_bf16(ob[0], ob[1]); w.w = cvt_pk_bf16(ob[2], ob[3]);
                *(GAS u32x4*)rowp = w;
            }
    }
};
struct EpiResid {
    static constexpr bool PERM = true;
    const float* base32; bf16_t* xb; float* out32; float alpha; float* P;
    __device__ __forceinline__ void operator()(const f32x4 (&acc)[2][2][4][2], const Unit& u, int wr, int wc, int fr, int fq, LAS float* cache, int& tag) const {
        const int row0 = u.pm * BM + wr * 64 + fr, col0 = u.pn * BM + wc * 32 + 8 * fq;
#pragma unroll
        for (int ai = 0; ai < 2; ++ai)
#pragma unroll
            for (int m = 0; m < 4; ++m) {
                const int row = row0 + ai * HALF + m * 16; const size_t off = (size_t)row * DM + col0; float ss = 0.f;
#pragma unroll
                for (int bj = 0; bj < 2; ++bj) {
                    f32x4 x0, x1;
                    if (base32) { x0 = *(const GAS f32x4*)(base32 + off + bj * HALF); x1 = *(const GAS f32x4*)(base32 + off + bj * HALF + 4); }
                    else { const u32x4 b = *(const GAS u32x4*)(xb + off + bj * HALF); x0 = (f32x4){bf_lo(b.x), bf_hi(b.x), bf_lo(b.y), bf_hi(b.y)}; x1 = (f32x4){bf_lo(b.z), bf_hi(b.z), bf_lo(b.w), bf_hi(b.w)}; }
                    x0 = x0 + acc[ai][bj][m][0] * alpha; x1 = x1 + acc[ai][bj][m][1] * alpha;
                    ss += ((x0.x * x0.x + x0.y * x0.y) + (x0.z * x0.z + x0.w * x0.w)) + ((x1.x * x1.x + x1.y * x1.y) + (x1.z * x1.z + x1.w * x1.w));
                    if (out32) { *(GAS f32x4*)(out32 + off + bj * HALF) = x0; *(GAS f32x4*)(out32 + off + bj * HALF + 4) = x1; }
                    else { u32x4 w; w.x = cvt_pk_bf16(x0.x, x0.y); w.y = cvt_pk_bf16(x0.z, x0.w); w.z = cvt_pk_bf16(x1.x, x1.y); w.w = cvt_pk_bf16(x1.z, x1.w); *(GAS u32x4*)(xb + off + bj * HALF) = w; }
                }
                ss += __shfl_xor(ss, 16); ss += __shfl_xor(ss, 32); if (fq == 0) ((GAS float*)P)[(size_t)row * 32 + u.pn * 4 + wc] = ss;
                if (m & 1) asm volatile("" ::: "memory");
            }
    }
};
struct EpiProj {
    static constexpr bool PERM = true;
    bf16_t* O0; int ld0; int nscale; float scale0; int gate_tile; float* gate; bf16_t* O1; int ld1; const float* P;
    __device__ __forceinline__ void operator()(const f32x4 (&acc)[2][2][4][2], const Unit& u, int wr, int wc, int fr, int fq, LAS float* cache, int& tag) const {
        const int row0 = u.pm * BM + wr * 64 + fr;
        float rs[2][4]; row_rstd(u.g ? nullptr : P, u.pm, row0, fq, fr + 16 * fq, cache, tag, rs);
        if (u.g == 0 && u.pn == gate_tile) {
            if (wc == 0 && fq < 2) {
#pragma unroll
                for (int ai = 0; ai < 2; ++ai)
#pragma unroll
                    for (int m = 0; m < 4; ++m) { float* gp = gate + (size_t)(row0 + ai * HALF + m * 16) * 16 + 8 * fq; *(GAS f32x4*)gp = acc[ai][0][m][0] * rs[ai][m]; *(GAS f32x4*)(gp + 4) = acc[ai][0][m][1] * rs[ai][m]; }
            }
            return;
        }
        bf16_t* base = u.g ? O1 : O0; const int ld = u.g ? ld1 : ld0; const float sc = (u.g == 0 && u.pn < nscale) ? scale0 : 1.0f;
        const int col0 = u.pn * BM + wc * 32 + 8 * fq;
#pragma unroll
        for (int ai = 0; ai < 2; ++ai)
#pragma unroll
            for (int m = 0; m < 4; ++m) {
                bf16_t* rowp = base + (size_t)(row0 + ai * HALF + m * 16) * ld + col0; const float r = sc * rs[ai][m];
#pragma unroll
                for (int bj = 0; bj < 2; ++bj) { const f32x4 v0 = acc[ai][bj][m][0] * r, v1 = acc[ai][bj][m][1] * r; u32x4 w; w.x = cvt_pk_bf16(v0[0], v0[1]); w.y = cvt_pk_bf16(v0[2], v0[3]); w.z = cvt_pk_bf16(v1[0], v1[1]); w.w = cvt_pk_bf16(v1[2], v1[3]);
                    *(GAS u32x4*)(rowp + bj * HALF) = w; }
            }
    }
};

template <class Epi>
__device__ __forceinline__ void gemm_phase(LAS unsigned char* lds, const GemmSet g, const Order& S, const Epi& E) {
    int tid = threadIdx.x; asm volatile("" : "+v"(tid));
    const int wid = __builtin_amdgcn_readfirstlane(tid >> 6), lane = tid & 63, wr = wid >> 2, wc = wid & 3, fr = lane & 15, fq = lane >> 4;
    const int K = g.K, nt = K / BK;
    unsigned voffA[2], voffB[2];
#pragma unroll
    for (int i = 0; i < 2; ++i) { int R, C; stage_rc(tid * 16 + i * 8192, R, C); const int Rb = Epi::PERM ? ((R & ~31) + perm32(R & 31)) : R;
        voffA[i] = (unsigned)(R * g.lda + C) * 2u; voffB[i] = (unsigned)(Rb * K + C) * 2u; }
    const size_t kstep = (size_t)(BK * 2);
    const size_t hstep = (size_t)HALF * K * 2;
    const size_t tstep = 2 * hstep;
    const size_t hstepA = (size_t)HALF * g.lda * 2, tstepA = 2 * hstepA;
    const unsigned ldsw = (unsigned)wid * 1024u;
    const int aoff = lds_byte(wr * 64 + fr, fq * 8), boff = lds_byte(wc * 32 + fr, fq * 8);
#define PG8_SA(b, h) (((b) * 2 + (h)) * HTB)
#define PG8_SB(b, h) ((4 + (b) * 2 + (h)) * HTB)
#define PG8_STAGE(bufoff, gbase, voff) do { _Pragma("unroll") for (int _i = 0; _i < 2; ++_i) \
        __builtin_amdgcn_global_load_lds((const unsigned*)((const char*)(gbase) + (voff)[_i]), (LAS unsigned*)(lds + (bufoff) + ldsw + _i * 8192), 16, 0, 0); } while (0)
#define PG8_LDA(dst, b, h) do { _Pragma("unroll") for (int m = 0; m < 4; ++m) _Pragma("unroll") for (int k = 0; k < 2; ++k) dst[m][k] = *(const LAS bf16x8*)(lds + PG8_SA(b, h) + aoff + m * 2048 + k * 1024); } while (0)
#define PG8_LDB(dst, b, h) do { _Pragma("unroll") for (int n = 0; n < 2; ++n) _Pragma("unroll") for (int k = 0; k < 2; ++k) dst[n][k] = *(const LAS bf16x8*)(lds + PG8_SB(b, h) + boff + n * 2048 + k * 1024); } while (0)
#define PG8_MMA(ai, bj, At, Bt) do { __builtin_amdgcn_s_setprio(1); _Pragma("unroll") for (int m = 0; m < 4; ++m) _Pragma("unroll") for (int n = 0; n < 2; ++n) _Pragma("unroll") for (int k = 0; k < 2; ++k) \
        acc[ai][bj][m][n] = __builtin_amdgcn_mfma_f32_16x16x32_bf16(Bt[n][k], At[m][k], acc[ai][bj][m][n], 0, 0, 0); __builtin_amdgcn_s_setprio(0); } while (0)
#define PG8_WAIT_V(n) asm volatile("s_waitcnt vmcnt(" #n ")" ::: "memory")
#define PG8_WAIT_L(n) asm volatile("s_waitcnt lgkmcnt(" #n ")" ::: "memory")
#define PG8_BAR __builtin_amdgcn_s_barrier()
#define PG8_SCHED __builtin_amdgcn_sched_barrier(0)
    Unit cur, nxt; int ui = 0;
    if (!S.next(0, cur)) return;
    LAS float* rcache = (LAS float*)(lds + STAGE_BYTES + 1024 + wid * 2048); int rtag = -1;
    f32x4 acc[2][2][4][2];
#pragma unroll
    for (int a = 0; a < 2; ++a)
#pragma unroll
        for (int b = 0; b < 2; ++b)
#pragma unroll
            for (int m = 0; m < 4; ++m)
#pragma unroll
                for (int n = 0; n < 2; ++n) acc[a][b][m][n] = (f32x4){0.f, 0.f, 0.f, 0.f};
    bf16x8 At[4][2], B0[2][2], B1[2][2];
    const char* cA = (const char*)(cur.g ? g.A1 : g.A0) + (size_t)cur.pm * tstepA; const char* cB = (const char*)(cur.g ? g.B1 : g.B0) + (size_t)cur.pn * tstep;
    PG8_STAGE(PG8_SB(0, 0), cB, voffB); PG8_STAGE(PG8_SB(0, 1), cB + hstep, voffB); PG8_STAGE(PG8_SA(0, 0), cA, voffA); PG8_STAGE(PG8_SA(0, 1), cA + hstepA, voffA);
    if (wr == 1) PG8_BAR;
    PG8_WAIT_V(2); PG8_BAR;
    PG8_STAGE(PG8_SB(1, 0), cB + kstep, voffB); PG8_STAGE(PG8_SA(1, 0), cA + kstep, voffA); PG8_STAGE(PG8_SB(1, 1), cB + hstep + kstep, voffB);
    PG8_WAIT_V(6); PG8_BAR;
    for (;;) {
        const bool has_next = S.next(ui + 1, nxt);
        const char* nA = has_next ? (const char*)(nxt.g ? g.A1 : g.A0) + (size_t)nxt.pm * tstepA : cA; const char* nB = has_next ? (const char*)(nxt.g ? g.B1 : g.B0) + (size_t)nxt.pn * tstep : cB;
        for (int t = 0; t < nt; t += 2) {
            const bool last = (t == nt - 2);
            const char* a1 = cA + (size_t)(t + 1) * kstep;
            const char* a2 = last ? nA : cA + (size_t)(t + 2) * kstep; const char* b2 = last ? nB : cB + (size_t)(t + 2) * kstep;
            const char* a3 = a2 + kstep; const char* b3 = b2 + kstep;
            PG8_LDB(B0, 0, 0); PG8_LDB(B1, 0, 1); PG8_SCHED; PG8_LDA(At, 0, 0); PG8_STAGE(PG8_SA(1, 1), a1 + hstepA, voffA);
            PG8_WAIT_V(8); PG8_WAIT_L(0); PG8_BAR; PG8_MMA(0, 0, At, B0); PG8_MMA(0, 1, At, B1); PG8_BAR; PG8_SCHED;
            PG8_LDA(At, 0, 1); PG8_STAGE(PG8_SB(0, 0), b2, voffB); PG8_STAGE(PG8_SB(0, 1), b2 + hstep, voffB); PG8_STAGE(PG8_SA(0, 0), a2, voffA);
            PG8_WAIT_V(8); PG8_WAIT_L(0); PG8_BAR; PG8_MMA(1, 0, At, B0); PG8_MMA(1, 1, At, B1); PG8_BAR; PG8_SCHED;
            PG8_LDB(B0, 1, 0); PG8_LDB(B1, 1, 1); PG8_SCHED; PG8_LDA(At, 1, 0); PG8_STAGE(PG8_SA(0, 1), a2 + hstepA, voffA);
            PG8_WAIT_V(8); PG8_WAIT_L(0); PG8_BAR; PG8_MMA(0, 0, At, B0); PG8_MMA(0, 1, At, B1); PG8_BAR; PG8_SCHED;
            PG8_LDA(At, 1, 1); PG8_STAGE(PG8_SB(1, 0), b3, voffB); PG8_STAGE(PG8_SB(1, 1), b3 + hstep, voffB); PG8_STAGE(PG8_SA(1, 0), a3, voffA);
            PG8_WAIT_V(8); PG8_WAIT_L(0); PG8_BAR; PG8_MMA(1, 0, At, B0); PG8_MMA(1, 1, At, B1); PG8_BAR; PG8_SCHED;
        }
        if (wr == 0) PG8_BAR;
        E(acc, cur, wr, wc, fr, fq, rcache, rtag);
        if (!has_next) break;
#pragma unroll
        for (int a = 0; a < 2; ++a)
#pragma unroll
            for (int b = 0; b < 2; ++b)
#pragma unroll
                for (int m = 0; m < 4; ++m)
#pragma unroll
                    for (int n = 0; n < 2; ++n) acc[a][b][m][n] = (f32x4){0.f, 0.f, 0.f, 0.f};
        cur = nxt; cA = nA; cB = nB; ++ui;
        if (wr == 1) PG8_BAR;
    }
    PG8_WAIT_V(0);
    PG8_BAR;
#undef PG8_SA
#undef PG8_SB
#undef PG8_STAGE
#undef PG8_LDA
#undef PG8_LDB
#undef PG8_MMA
#undef PG8_WAIT_V
#undef PG8_WAIT_L
#undef PG8_BAR
#undef PG8_SCHED
}
}

namespace att {
constexpr int KROW = 272, VROW = 144, KBUF = 64 * KROW, VBUF = 128 * VROW;
constexpr int OFF_K = 0, OFF_V = 2 * KBUF, OFF_BIAS = OFF_V + 2 * VBUF, OFF_RED = OFF_BIAS + 8192;
struct Args {
    const bf16_t* Q; const bf16_t* K; const bf16_t* V; bf16_t* O; float* lse;
    int q_pitch, kv_pitch, o_pitch, lse_pitch;
    int q_tok0, k_tok0, dil, logL;
    int q0, kt_lo, kt_hi;
    const float* aux; float bf;
};
__device__ __forceinline__ int crow(int r, int hi) { return (r & 3) + 8 * (r >> 2) + 4 * hi; }

template <int MODE>
__device__ __forceinline__ void unit(LAS unsigned char* lds, const Args& a) {
    int tid = threadIdx.x; asm volatile("" : "+v"(tid));
    const int lane = tid & 63, wid = __builtin_amdgcn_readfirstlane(tid >> 6), r32 = lane & 31, hi = lane >> 5;
    const int Lm1 = (1 << a.logL) - 1;
#define ATOK(base, p) ((base) + ((p) >> a.logL) + ((p) & Lm1) * a.dil)
    LAS float* bl = (LAS float*)(lds + OFF_BIAS);
    if (MODE == 1) {
        LAS float* red = (LAS float*)(lds + OFF_RED);
        const float* gz = a.aux + (size_t)a.k_tok0 * 16;
        float v[4];
#pragma unroll
        for (int e = 0; e < 4; ++e) { const float y = ((const GAS float*)gz)[(size_t)(4 * tid + e) * 16] + a.bf; v[e] = fminf(y, 0.f) - log1pf(expf(-fabsf(y))); }
        v[1] += v[0]; v[2] += v[1]; v[3] += v[2];
        const float tot = v[3]; float sc = tot;
#pragma unroll
        for (int o = 1; o < 64; o <<= 1) { const float n = __shfl_up(sc, o); if (lane >= o) sc += n; }
        if (lane == 63) red[wid] = sc;
        __syncthreads();
        float woff = 0.f;
        for (int w = 0; w < wid; ++w) woff += red[w];
        const float excl = woff + sc - tot;
#pragma unroll
        for (int e = 0; e < 4; ++e) bl[4 * tid + e] = -(excl + v[e]) * LOG2E;
    } else if (MODE == 2) {
        if (tid < 320) bl[tid] = -1e30f;
        __syncthreads();
        if (tid <= 128) {
            const int d = tid * a.dil; int bucket;
            if (d < 16) bucket = d;
            else {
                bucket = 16 + (d >= 22) + (d >= 30) + (d >= 40) + (d >= 54) + (d >= 73) + (d >= 99) + (d >= 134) + (d >= 182) + (d >= 246) + (d >= 332) + (d >= 450) + (d >= 609) + (d >= 825) + (d >= 1117) + (d >= 1513);
            }
            bl[96 + tid] = ((const GAS float*)a.aux)[bucket * DILH] * LOG2E;
        }
    }
    const int qlo = a.q0 + 32 * wid, qp = qlo + r32;
    const size_t qtok = (size_t)ATOK(a.q_tok0, qp);
    bf16x8 qf[8];
    { const bf16_t* qrow = a.Q + qtok * a.q_pitch + 8 * hi;
#pragma unroll
      for (int ks = 0; ks < 8; ++ks) qf[ks] = *(const GAS bf16x8*)(qrow + 16 * ks); }
    f32x16 o[4];
#pragma unroll
    for (int db = 0; db < 4; ++db)
#pragma unroll
        for (int r = 0; r < 16; ++r) o[db][r] = 0.f;
    float mrun = -1e29f, lrun = 0.f;
    u32x4 kreg[2], vreg[2];
#define LOAD_TILE(kt) do { _Pragma("unroll") for (int i_ = 0; i_ < 2; ++i_) { const int id_ = tid + 512 * i_; \
        { const int row_ = id_ >> 4, ch_ = id_ & 15, kp_ = 64 * (kt) + row_; kreg[i_] = *(const GAS u32x4*)(a.K + (size_t)ATOK(a.k_tok0, kp_) * a.kv_pitch + ch_ * 8); } \
        { const int kv_ = id_ & 63, ch_ = id_ >> 6, kp_ = 64 * (kt) + kv_; vreg[i_] = *(const GAS u32x4*)(a.V + (size_t)ATOK(a.k_tok0, kp_) * a.kv_pitch + ch_ * 8); } } } while (0)
#define STORE_TILE(buf) do { _Pragma("unroll") for (int i_ = 0; i_ < 2; ++i_) { const int id_ = tid + 512 * i_; \
        { const int row_ = id_ >> 4, ch_ = id_ & 15; *(LAS u32x4*)(lds + OFF_K + (buf) * KBUF + row_ * KROW + ch_ * 16) = kreg[i_]; } \
        { const int kv_ = id_ & 63, ch_ = id_ >> 6; const int pos_ = (kv_ & ~15) | (kv_ & 3) | ((kv_ & 4) << 1) | ((kv_ & 8) >> 1); \
          LAS unsigned short* vp_ = (LAS unsigned short*)(lds + OFF_V + (buf) * VBUF + (8 * ch_) * VROW + pos_ * 2); \
          _Pragma("unroll") for (int e_ = 0; e_ < 8; ++e_) vp_[e_ * (VROW / 2)] = (unsigned short)(vreg[i_][e_ >> 1] >> (16 * (e_ & 1))); } } } while (0)
    constexpr bool REV = (MODE == 1);
    const int ntile = a.kt_hi - a.kt_lo;
    LOAD_TILE(REV ? a.kt_hi - 1 : a.kt_lo); STORE_TILE(0);
    __syncthreads();
    for (int it = 0; it < ntile; ++it) {
        const int kt = REV ? a.kt_hi - 1 - it : a.kt_lo + it;
        const int buf = it & 1;
        const bool more = it + 1 < ntile;
        if (more) LOAD_TILE(REV ? kt - 1 : kt + 1);
        const int klo = 64 * kt;
        bool skip = false, need_mask = false;
        if (MODE == 1) { skip = klo > qlo + 31; need_mask = klo + 63 > qlo; }
        if (MODE == 2) { skip = (klo > qlo + 31) || (klo + 63 < qlo - 128) || ((klo >> a.logL) != (qlo >> a.logL)); need_mask = true; }
        if (!skip) {
            f32x16 s0, s1;
#pragma unroll
            for (int r = 0; r < 16; ++r) { s0[r] = 0.f; s1[r] = 0.f; }
            const LAS unsigned char* kb = lds + OFF_K + buf * KBUF + r32 * KROW + hi * 16;
#pragma unroll
            for (int ks = 0; ks < 8; ++ks) {
                const bf16x8 a0 = *(const LAS bf16x8*)(kb + ks * 32); const bf16x8 a1 = *(const LAS bf16x8*)(kb + 32 * KROW + ks * 32);
                s0 = __builtin_amdgcn_mfma_f32_32x32x16_bf16(a0, qf[ks], s0, 0, 0, 0); s1 = __builtin_amdgcn_mfma_f32_32x32x16_bf16(a1, qf[ks], s1, 0, 0, 0);
            }
            if (MODE == 1) {
#pragma unroll
                for (int g4 = 0; g4 < 4; ++g4) { const f32x4 b0 = *(const LAS f32x4*)(bl + klo + 8 * g4 + 4 * hi), b1 = *(const LAS f32x4*)(bl + klo + 32 + 8 * g4 + 4 * hi);
#pragma unroll
                    for (int j = 0; j < 4; ++j) { s0[4 * g4 + j] += b0[j]; s1[4 * g4 + j] += b1[j]; } }
                if (need_mask) {
#pragma unroll
                    for (int r = 0; r < 16; ++r) { const int kp0 = klo + crow(r, hi); if (kp0 > qp) s0[r] = -1e30f; if (kp0 + 32 > qp) s1[r] = -1e30f; }
                }
            }
            if (MODE == 2) {
                const LAS float* tb = bl + (qp - klo - 4 * hi + 96 - 59);
#pragma unroll
                for (int r = 0; r < 16; ++r) { const int c = (r & 3) + 8 * (r >> 2); s0[r] += tb[59 - c]; s1[r] += tb[59 - c - 32]; }
            }
#define MX3(a_, b_, c_) __builtin_fmaxf(__builtin_fmaxf((a_), (b_)), (c_))
            float ma = MX3(s0[0], s0[1], s1[0]), mb = MX3(s0[2], s0[3], s1[1]); ma = MX3(ma, s1[2], s1[3]);
#pragma unroll
            for (int r = 4; r < 16; r += 4) { ma = MX3(ma, s0[r], s0[r + 1]); mb = MX3(mb, s0[r + 2], s0[r + 3]); ma = MX3(ma, s1[r], s1[r + 1]); mb = MX3(mb, s1[r + 2], s1[r + 3]); }
#undef MX3
            float rm = fmaxf(ma, mb);
            rm = fmaxf(rm, __shfl_xor(rm, 32));
            const float mn = fmaxf(mrun, rm); const float alpha = __builtin_amdgcn_exp2f(mrun - mn); mrun = mn;
            float ps = 0.f;
#pragma unroll
            for (int r = 0; r < 16; ++r) { s0[r] = __builtin_amdgcn_exp2f(s0[r] - mn); s1[r] = __builtin_amdgcn_exp2f(s1[r] - mn); ps += s0[r] + s1[r]; }
            lrun = lrun * alpha + ps;
            if (__any(alpha != 1.0f)) {
#pragma unroll
                for (int db = 0; db < 4; ++db)
#pragma unroll
                    for (int r = 0; r < 16; ++r) o[db][r] *= alpha;
            }
            bf16x8 pj[4];
#pragma unroll
            for (int jj = 0; jj < 2; ++jj) {
                u32x4 w0, w1;
                w0.x = cvt_pk_bf16(s0[8 * jj + 0], s0[8 * jj + 1]); w0.y = cvt_pk_bf16(s0[8 * jj + 2], s0[8 * jj + 3]); w0.z = cvt_pk_bf16(s0[8 * jj + 4], s0[8 * jj + 5]); w0.w = cvt_pk_bf16(s0[8 * jj + 6], s0[8 * jj + 7]);
                w1.x = cvt_pk_bf16(s1[8 * jj + 0], s1[8 * jj + 1]); w1.y = cvt_pk_bf16(s1[8 * jj + 2], s1[8 * jj + 3]); w1.z = cvt_pk_bf16(s1[8 * jj + 4], s1[8 * jj + 5]); w1.w = cvt_pk_bf16(s1[8 * jj + 6], s1[8 * jj + 7]);
                pj[jj] = __builtin_bit_cast(bf16x8, w0); pj[2 + jj] = __builtin_bit_cast(bf16x8, w1);
            }
            const LAS unsigned char* vb = lds + OFF_V + buf * VBUF + r32 * VROW + hi * 16;
#pragma unroll
            for (int db = 0; db < 4; ++db)
#pragma unroll
                for (int j = 0; j < 4; ++j) { const bf16x8 va = *(const LAS bf16x8*)(vb + db * 32 * VROW + j * 32); o[db] = __builtin_amdgcn_mfma_f32_32x32x16_bf16(va, pj[j], o[db], 0, 0, 0); }
        }
        if (more) STORE_TILE(buf ^ 1);
        __syncthreads();
    }
    lrun += __shfl_xor(lrun, 32);
    const float inv = 1.0f / lrun;
    bf16_t* orow = a.O + qtok * a.o_pitch;
#pragma unroll
    for (int db = 0; db < 4; ++db)
#pragma unroll
        for (int g4 = 0; g4 < 4; ++g4) { u32x2 w; w.x = cvt_pk_bf16(o[db][4 * g4] * inv, o[db][4 * g4 + 1] * inv); w.y = cvt_pk_bf16(o[db][4 * g4 + 2] * inv, o[db][4 * g4 + 3] * inv);
            *(GAS u32x2*)(orow + 32 * db + 8 * g4 + 4 * hi) = w; }
    if (MODE == 2) { if (hi == 0) ((GAS float*)a.lse)[qtok * a.lse_pitch] = (mrun + log2f(lrun)) * LN2; }
#undef LOAD_TILE
#undef STORE_TILE
#undef ATOK
}
}


__device__ __forceinline__ unsigned xb_xcc_id() { return (unsigned)__builtin_amdgcn_s_getreg((3 << 11) | 20) & 0xFu; }
__device__ __forceinline__ void group_barrier(unsigned* cnt, unsigned n, int wb) {
    asm volatile("s_waitcnt vmcnt(0)" ::: "memory");
    __syncthreads();
    if (threadIdx.x == 0) {
        if (wb) { __builtin_amdgcn_fence(__ATOMIC_RELEASE, "agent"); asm volatile("s_waitcnt vmcnt(0)" ::: "memory"); }
        const unsigned old = __hip_atomic_fetch_add(cnt, 1u, __ATOMIC_RELAXED, __HIP_MEMORY_SCOPE_AGENT);
        const unsigned target = (old / n + 1u) * n;
        unsigned sp = 0u;
        while (__hip_atomic_load(cnt, __ATOMIC_RELAXED, __HIP_MEMORY_SCOPE_AGENT) < target) { __builtin_amdgcn_s_sleep(1); if (++sp > (1u << 26)) break; }
        __builtin_amdgcn_fence(__ATOMIC_ACQUIRE, "agent");
        asm volatile("s_waitcnt vmcnt(0)" ::: "memory");
    }
    __syncthreads();
}
struct Topo {
    unsigned* xcnt; unsigned* pcnt; unsigned nx, np; int wb, fast;
    int b0, NB, nloc, k;
    int pm, member;
};

__device__ __forceinline__ int dest_row(int kind, int n) { if (kind == 0) return n; const int half = n >= DFF ? 1 : 0, c = n - half * DFF; return 256 * (c >> 7) + 128 * half + (c & 127); }
__device__ __forceinline__ void transpose_item(const float* W, int K, int N, bf16_t* WT, int kind, const float* gfold, LAS float* scr, int item, int lane) {
    const int nblk = (N + 31) / 32, kb = item / nblk, nb = item % nblk, k0 = 64 * kb, n0 = 32 * nb;
    const int nn = n0 + 4 * (lane & 7); const bool ok = nn < N;
    f32x4 v[8];
#pragma unroll
    for (int i = 0; i < 8; ++i) { const int kk = 8 * i + (lane >> 3); v[i] = ok ? __builtin_nontemporal_load((const GAS f32x4*)(W + (size_t)(k0 + kk) * N + nn)) : (f32x4){0.f, 0.f, 0.f, 0.f}; }
    if (gfold) {
#pragma unroll
        for (int i = 0; i < 8; ++i) v[i] = v[i] * ((const GAS float*)gfold)[k0 + 8 * i + (lane >> 3)];
    }
#pragma unroll
    for (int i = 0; i < 8; ++i) { LAS float* d = scr + (8 * i + (lane >> 3)) * 33 + 4 * (lane & 7); d[0] = v[i].x; d[1] = v[i].y; d[2] = v[i].z; d[3] = v[i].w; }
    asm volatile("s_waitcnt lgkmcnt(0)" ::: "memory");
    const int c = lane & 7;
#pragma unroll
    for (int j = 0; j < 4; ++j) { const int n = (lane >> 3) + 8 * j; const LAS float* s = scr + (8 * c) * 33 + n;
        u32x4 o; o.x = cvt_pk_bf16(s[0 * 33], s[1 * 33]); o.y = cvt_pk_bf16(s[2 * 33], s[3 * 33]); o.z = cvt_pk_bf16(s[4 * 33], s[5 * 33]); o.w = cvt_pk_bf16(s[6 * 33], s[7 * 33]);
        *(GAS u32x4*)(WT + (size_t)dest_row(kind, n0 + n) * K + k0 + 8 * c) = o; }
    asm volatile("s_waitcnt lgkmcnt(0)" ::: "memory");
}
__device__ __forceinline__ void convert_matrix(const float* W, int K, int N, bf16_t* WT, int kind, const float* gfold, LAS float* scr, int gw, int ngw, int lane) {
    asm volatile("" : "+v"(lane));
    const int nitems = (K / 64) * ((N + 31) / 32);
    for (int it = gw; it < nitems; it += ngw) transpose_item(W, K, N, WT, kind, gfold, scr, it, lane);
}
__device__ __forceinline__ void gate_mini(const bf16_t* xb, const float* P, const bf16_t* Wg, float* gate, int row0, int tid) {
    asm volatile("" : "+v"(tid));
    const int lane = tid & 63, wid = __builtin_amdgcn_readfirstlane(tid >> 6);
    if (wid >= 4) return;
    const int r = lane & 15, kq = lane >> 4, row = row0 + 16 * wid + r;
    const bf16_t* ap = xb + (size_t)row * DM + 8 * kq;
    const bf16_t* bp = Wg + (size_t)r * DM + 8 * kq;
    f32x4 acc = {0.f, 0.f, 0.f, 0.f};
#pragma unroll 8
    for (int kk = 0; kk < 64; ++kk) {
        const bf16x8 a = *(const GAS bf16x8*)(ap + 32 * kk), b = *(const GAS bf16x8*)(bp + 32 * kk);
        acc = __builtin_amdgcn_mfma_f32_16x16x32_bf16(a, b, acc, 0, 0, 0);
    }
    const float* pp = P + (size_t)row * 32 + 8 * kq;
    const f32x4 p0 = *(const GAS f32x4*)pp, p1 = *(const GAS f32x4*)(pp + 4);
    float s = ((p0.x + p0.y) + (p0.z + p0.w)) + ((p1.x + p1.y) + (p1.z + p1.w)); s += __shfl_xor(s, 16); s += __shfl_xor(s, 32);
    const float rs = __builtin_amdgcn_rsqf(s * (1.0f / DM) + RMS_EPS);
#pragma unroll
    for (int j = 0; j < 4; ++j) { const float rr = __shfl(rs, 4 * kq + j); ((GAS float*)gate)[(size_t)(row0 + 16 * wid + 4 * kq + j) * 16 + r] = acc[j] * rr; }
}
__device__ __forceinline__ void rows_to_xb(const float* x, bf16_t* xb, float* P, int nrows, int gw, int ngw, int lane) {
    asm volatile("" : "+v"(lane));
    for (int m = gw; m < nrows; m += ngw) {
        const float* xr = x + (size_t)m * DM + 4 * lane; f32x4 v[8]; float s = 0.f;
#pragma unroll
        for (int j = 0; j < 8; ++j) { v[j] = *(const GAS f32x4*)(xr + 256 * j); s += (v[j].x * v[j].x + v[j].y * v[j].y) + (v[j].z * v[j].z + v[j].w * v[j].w); }
        s = wave_sum(s);
        bf16_t* orow = xb + (size_t)m * DM + 4 * lane;
#pragma unroll
        for (int j = 0; j < 8; ++j) { u32x2 w; w.x = cvt_pk_bf16(v[j].x, v[j].y); w.y = cvt_pk_bf16(v[j].z, v[j].w); *(GAS u32x2*)(orow + 256 * j) = w; }
        if (lane < 32) ((GAS float*)P)[(size_t)m * 32 + lane] = lane == 0 ? s : 0.f;
    }
}
__device__ __forceinline__ void rms_rows_bf16(const float* x, const float* g, bf16_t* out, int out_pitch, int nrows, int gw, int ngw, int lane) {
    asm volatile("" : "+v"(lane));
    f32x4 gg[8];
#pragma unroll
    for (int j = 0; j < 8; ++j) gg[j] = *(const GAS f32x4*)(g + 4 * lane + 256 * j);
    for (int m = gw; m < nrows; m += ngw) {
        const float* xr = x + (size_t)m * DM + 4 * lane; f32x4 v[8]; float s = 0.f;
#pragma unroll
        for (int j = 0; j < 8; ++j) { v[j] = *(const GAS f32x4*)(xr + 256 * j); s += (v[j].x * v[j].x + v[j].y * v[j].y) + (v[j].z * v[j].z + v[j].w * v[j].w); }
        const float rstd = 1.0f / sqrtf(wave_sum(s) * (1.0f / DM) + RMS_EPS);
        bf16_t* orow = out + (size_t)m * out_pitch + 4 * lane;
#pragma unroll
        for (int j = 0; j < 8; ++j) { u32x2 w; w.x = cvt_pk_bf16(v[j].x * rstd * gg[j].x, v[j].y * rstd * gg[j].y); w.y = cvt_pk_bf16(v[j].z * rstd * gg[j].z, v[j].w * rstd * gg[j].w); *(GAS u32x2*)(orow + 256 * j) = w; }
    }
}
__device__ __forceinline__ void rms_rows_f32_inplace(float* x, const float* g, int nrows, int gw, int ngw, int lane) {
    asm volatile("" : "+v"(lane));
    f32x4 gg[8];
#pragma unroll
    for (int j = 0; j < 8; ++j) gg[j] = *(const GAS f32x4*)(g + 4 * lane + 256 * j);
    for (int m = gw; m < nrows; m += ngw) {
        float* xr = x + (size_t)m * DM + 4 * lane; f32x4 v[8]; float s = 0.f;
#pragma unroll
        for (int j = 0; j < 8; ++j) { v[j] = *(const GAS f32x4*)(xr + 256 * j); s += (v[j].x * v[j].x + v[j].y * v[j].y) + (v[j].z * v[j].z + v[j].w * v[j].w); }
        const float rstd = 1.0f / sqrtf(wave_sum(s) * (1.0f / DM) + RMS_EPS);
#pragma unroll
        for (int j = 0; j < 8; ++j) *(GAS f32x4*)(xr + 256 * j) = v[j] * rstd * gg[j];
    }
}

struct KArgs { const float* in[21]; float* out; unsigned char* ws; };
#define PHASE_BEGIN { unsigned char* ws = args.ws; asm volatile("" : "+s"(ws)); float* xr = args.out; asm volatile("" : "+s"(xr)); \
    bf16_t* HB = (bf16_t*)(ws + WS_HB); bf16_t* ACT = (bf16_t*)(ws + WS_ACT); bf16_t* CQ = (bf16_t*)(ws + WS_CQ); bf16_t* CO = (bf16_t*)(ws + WS_CO); \
    bf16_t* MEMN = (bf16_t*)(ws + WS_MEMN); bf16_t* KVB = (bf16_t*)(ws + WS_KV); float* GATE = (float*)(ws + WS_GATE); float* LSE = (float*)(ws + WS_LSE); bf16_t* XB = (bf16_t*)(ws + WS_XB); float* PP = (float*)(ws + WS_P); \
    (void)XB; (void)PP; (void)HB; (void)ACT; (void)CQ; (void)CO; (void)MEMN; (void)KVB; (void)GATE; (void)LSE; (void)xr;
#define SEAM_P      group_barrier(T.pcnt, T.np, T.wb); }
#define SEAM_X      group_barrier(T.xcnt, T.nx, T.wb); }
#define PHASE_END_LAST }

#define PH_PARAMS const KArgs& args, LAS unsigned char* lds, const Topo& T, const int G, const int bx, const int gw, const int ngw, const int lane, const int tid
#define PH_ARGS args, lds, T, G, bx, gw, ngw, lane, tid

template <int layer> __device__ __forceinline__ void mixer_phases(PH_PARAMS) {
                PHASE_BEGIN
                {
                    pg8::GemmSet g; g.A0 = XB; g.B0 = (const bf16_t*)(ws + (layer == 0 ? WS_FOX_IN : WS_DIL_IN)); g.A1 = MEMN; g.B1 = (const bf16_t*)(ws + WS_CKV_W + (size_t)layer * 4 * MiB); g.K = DM; g.lda = DM;
                    if (layer == 0) {
                        const bf16_t* Wg = (const bf16_t*)(ws + WS_FOX_IN) + (size_t)FOX_QKV * DM;
                        if (T.fast) gate_mini(XB, PP, Wg, GATE, 256 * T.pm + 64 * T.member, tid);
                        else for (int blk = bx; blk < TOK / 64; blk += G) gate_mini(XB, PP, Wg, GATE, 64 * blk, tid);
                    }
                    pg8::Order S; if (layer == 0) S.init(TOK, FOX_QKV, 0, 0, G, bx); else S.init(TOK, DIL_N, TMEM, CR_KV, G, bx);
                    pg8::EpiProj E; E.O0 = ACT; E.ld0 = ACT_LD; E.nscale = layer == 0 ? 8 : 9; E.scale0 = QSCALE; E.gate_tile = -1; E.gate = GATE; E.P = PP;
                    E.O1 = KVB + (size_t)layer * TMEM * CR_KV; E.ld1 = CR_KV;
                    pg8::gemm_phase<pg8::EpiProj>(lds, g, S, E);
                }
                SEAM_X
                PHASE_BEGIN
                if (layer == 0) {
                    for (int i = 0;; ++i) {
                        const int p = i * T.nloc + ((i & 1) ? (T.nloc - 1 - T.k) : T.k);
                        if (p >= T.NB * 128) break;
                        const int qb = 7 - p / (16 * T.NB), rest = p % (16 * T.NB), b = T.b0 + (rest >> 4), h = rest & 15;
                        att::Args a; a.Q = ACT + h * 128; a.K = ACT + 2048 + h * 128; a.V = ACT + 4096 + h * 128; a.O = HB + h * 128; a.lse = nullptr;
                        a.q_pitch = ACT_LD; a.kv_pitch = ACT_LD; a.o_pitch = HB_LD; a.lse_pitch = 0; a.q_tok0 = b * SEQ; a.k_tok0 = b * SEQ; a.dil = 1; a.logL = 20;
                        a.q0 = 256 * qb; a.kt_lo = 0; a.kt_hi = 4 * (qb + 1); a.aux = GATE + h; a.bf = ((const GAS float*)args.in[7])[h];
                        att::unit<1>(lds, a);
                    }
                } else {
                    for (int i = 0;; ++i) {
                        const int p = i * T.nloc + T.k;
                        if (p >= T.NB * 144) break;
                        const int grp = p / (48 * T.NB), rr = p % (48 * T.NB), b = T.b0 + rr / 48, r = rr % 48, gh = r >> 3, sub = r & 7;
                        int rho = 0, q0 = 0, dil, logL;
                        if (grp == 0) { dil = 1; logL = 11; q0 = 256 * sub; }
                        else if (grp == 1) { rho = sub >> 1; dil = 4; logL = 9; q0 = 256 * (sub & 1); }
                        else { rho = 2 * sub; dil = 16; logL = 7; q0 = 0; }
                        const int head = grp * 6 + gh;
                        att::Args a; a.Q = ACT + head * 128; a.K = ACT + DIL_HD + head * 128; a.V = ACT + 2 * DIL_HD + head * 128; a.O = HB + head * 128; a.lse = LSE + head;
                        a.q_pitch = ACT_LD; a.kv_pitch = ACT_LD; a.o_pitch = HB_LD; a.lse_pitch = DILH; a.q_tok0 = b * SEQ + rho; a.k_tok0 = b * SEQ + rho; a.dil = dil; a.logL = logL;
                        a.q0 = q0; a.kt_lo = (q0 >= 128 ? q0 - 128 : 0) >> 6; a.kt_hi = (q0 + 256) >> 6; a.aux = args.in[11] + head; a.bf = 0.f;
                        att::unit<2>(lds, a);
                    }
                }
                SEAM_X
                if (layer == 1) {
                    PHASE_BEGIN
                    int tid_l = tid; asm volatile("" : "+v"(tid_l));
                    const long i0 = T.fast ? (long)(256 * T.pm + 64 * T.member) * 288 + tid_l : (long)bx * 512 + tid_l;
                    const long i1 = T.fast ? (long)(256 * T.pm + 64 * T.member + 64) * 288 : (long)TOK * 288, istep = T.fast ? 512 : (long)G * 512;
                    for (long idx = i0; idx < i1; idx += istep) {
                        const int t = (int)(idx / 288), cc = (int)(idx % 288), head = cc >> 4, gh = head % 6, grp = head / 6;
                        const GAS float* lsg = (const GAS float*)LSE; const float l0 = lsg[(size_t)t * DILH + gh], l1 = lsg[(size_t)t * DILH + 6 + gh], l2 = lsg[(size_t)t * DILH + 12 + gh];
                        const float mx = fmaxf(l0, fmaxf(l1, l2)); const float e0 = expf(l0 - mx), e1 = expf(l1 - mx), e2 = expf(l2 - mx);
                        const float al = (grp == 0 ? e0 : (grp == 1 ? e1 : e2)) / (e0 + e1 + e2);
                        GAS u32x4* p = (GAS u32x4*)(HB + (size_t)t * DIL_HD + cc * 8); u32x4 v = *p;
                        v.x = cvt_pk_bf16(bf_lo(v.x) * al, bf_hi(v.x) * al); v.y = cvt_pk_bf16(bf_lo(v.y) * al, bf_hi(v.y) * al); v.z = cvt_pk_bf16(bf_lo(v.z) * al, bf_hi(v.z) * al); v.w = cvt_pk_bf16(bf_lo(v.w) * al, bf_hi(v.w) * al);
                        *p = v;
                    }
                    SEAM_P
                }
                PHASE_BEGIN
                {
                    pg8::GemmSet g; g.A0 = HB; g.B0 = (const bf16_t*)(ws + (layer == 0 ? WS_FOX_OUT : WS_DIL_OUT)); g.A1 = nullptr; g.B1 = nullptr; g.K = layer == 0 ? DM : DIL_HD; g.lda = HB_LD;
                    pg8::Order S; S.init(TOK, DM, 0, 0, G, bx);
                    pg8::EpiResid E; E.base32 = nullptr; E.xb = XB; E.out32 = nullptr; E.alpha = 1.0f; E.P = PP;
                    pg8::gemm_phase<pg8::EpiResid>(lds, g, S, E);
                }
                SEAM_P
                PHASE_BEGIN
                {
                    pg8::GemmSet g; g.A0 = XB; g.B0 = (const bf16_t*)(ws + WS_CQ_W + (size_t)layer * 2 * MiB); g.A1 = MEMN; g.B1 = (const bf16_t*)(ws + WS_CKV_W); g.K = DM; g.lda = DM;
                    pg8::Order S; if (layer == 0) S.init(TOK, CR_HD, TMEM, CR_KV, G, bx); else S.init(TOK, CR_HD, 0, 0, G, bx);
                    pg8::EpiProj E; E.O0 = CQ; E.ld0 = CR_HD; E.nscale = 2; E.scale0 = QSCALE; E.gate_tile = -1; E.gate = nullptr; E.O1 = KVB; E.ld1 = CR_KV; E.P = PP;
                    pg8::gemm_phase<pg8::EpiProj>(lds, g, S, E);
                }
                if (layer == 0) group_barrier(T.xcnt, T.nx, T.wb); else group_barrier(T.pcnt, T.np, T.wb); }
                PHASE_BEGIN
                for (int i = 0;; ++i) {
                    const int p = i * T.nloc + T.k;
                    if (p >= T.NB * 32) break;
                    const int qb = p & 7, h = (p >> 3) & 3, b = T.b0 + (p >> 5);
                    const bf16_t* kv = KVB + (size_t)layer * TMEM * CR_KV;
                    att::Args a; a.Q = CQ + h * 128; a.K = kv + h * 128; a.V = kv + CR_HD + h * 128; a.O = CO + h * 128; a.lse = nullptr;
                    a.q_pitch = CR_HD; a.kv_pitch = CR_KV; a.o_pitch = CR_HD; a.lse_pitch = 0; a.q_tok0 = b * SEQ; a.k_tok0 = b * NMEM; a.dil = 1; a.logL = 20;
                    a.q0 = 256 * qb; a.kt_lo = 0; a.kt_hi = 4; a.aux = nullptr; a.bf = 0.f;
                    att::unit<0>(lds, a);
                }
                SEAM_P
                PHASE_BEGIN
                {
                    pg8::GemmSet g; g.A0 = CO; g.B0 = (const bf16_t*)(ws + WS_CO_W + (size_t)layer * 2 * MiB); g.A1 = nullptr; g.B1 = nullptr; g.K = CR_HD; g.lda = CR_HD;
                    pg8::Order S; S.init(TOK, DM, 0, 0, G, bx);
                    pg8::EpiResid E; E.base32 = nullptr; E.xb = XB; E.out32 = nullptr; E.alpha = 1.0f; E.P = PP;
                    pg8::gemm_phase<pg8::EpiResid>(lds, g, S, E);
                }
                SEAM_P
}
template <int layer, int f> __device__ __forceinline__ void ffn_phases(PH_PARAMS) {
            PHASE_BEGIN
            {
                pg8::GemmSet g; g.A0 = XB; g.B0 = (const bf16_t*)(ws + WS_FFN_IN + (size_t)(2 * layer + f) * SZ_FFN_IN); g.A1 = nullptr; g.B1 = nullptr; g.K = DM; g.lda = DM;
                pg8::Order S; S.init(TOK, 2 * DFF, 0, 0, G, bx);
                pg8::EpiSwiglu E; E.O = ACT; E.P = PP;
                pg8::gemm_phase<pg8::EpiSwiglu>(lds, g, S, E);
            }
            SEAM_P
            PHASE_BEGIN
            {
                pg8::GemmSet g; g.A0 = ACT; g.B0 = (const bf16_t*)(ws + WS_FFN_OUT + (size_t)(2 * layer + f) * SZ_FFN_OUT); g.A1 = nullptr; g.B1 = nullptr; g.K = DFF; g.lda = ACT_LD;
                pg8::Order S; S.init(TOK, DM, 0, 0, G, bx);
                pg8::EpiResid E; E.base32 = (layer == 0 && f == 0) ? args.in[0] : nullptr; E.xb = XB; E.out32 = (layer == 1 && f == 1) ? xr : nullptr; E.alpha = 0.5f; E.P = PP;
                pg8::gemm_phase<pg8::EpiResid>(lds, g, S, E);
            }
            SEAM_P
}

__global__ void __launch_bounds__(512, 2) fwd_megakernel(KArgs args) {
    extern __shared__ __attribute__((aligned(16))) unsigned char lds_raw[];
    LAS unsigned char* lds = (LAS unsigned char*)lds_raw;
    cg::grid_group grid = cg::this_grid();
    const int tid = threadIdx.x, lane = tid & 63, wave = __builtin_amdgcn_readfirstlane(tid >> 6);
    const int G = gridDim.x, bx = blockIdx.x;
    const int gw = bx * 8 + wave, ngw = G * 8;
    unsigned* ctl = (unsigned*)(args.ws + WS_BAR);
    if (bx == 0) for (int i = tid; i < 8192; i += 512) __hip_atomic_store(ctl + i, 0u, __ATOMIC_RELAXED, __HIP_MEMORY_SCOPE_AGENT);
    if (tid == 0) __hip_atomic_store(ctl + 8192 + bx, xb_xcc_id() + 1u, __ATOMIC_RELAXED, __HIP_MEMORY_SCOPE_AGENT);
    PHASE_BEGIN
    {
        LAS float* scr = (LAS float*)(lds + wave * 16384);
        convert_matrix(args.in[19] + (size_t)DFF * DM, DFF, DM, (bf16_t*)(ws + WS_FFN_OUT + (size_t)3 * SZ_FFN_OUT), 0, nullptr, scr, gw, ngw, lane);
        convert_matrix(args.in[18] + (size_t)DM * 2 * DFF, DM, 2 * DFF, (bf16_t*)(ws + WS_FFN_IN + (size_t)3 * SZ_FFN_IN), 1, args.in[17] + DM, scr, gw, ngw, lane);
        convert_matrix(args.in[16] + (size_t)CR_HD * DM, CR_HD, DM, (bf16_t*)(ws + WS_CO_W + (size_t)2 * MiB), 0, nullptr, scr, gw, ngw, lane);
        convert_matrix(args.in[14] + (size_t)DM * CR_HD, DM, CR_HD, (bf16_t*)(ws + WS_CQ_W + (size_t)2 * MiB), 0, args.in[12] + DM, scr, gw, ngw, lane);
        convert_matrix(args.in[10], DIL_HD, DM, (bf16_t*)(ws + WS_DIL_OUT), 0, nullptr, scr, gw, ngw, lane);
        convert_matrix(args.in[15] + (size_t)DM * CR_KV, DM, CR_KV, (bf16_t*)(ws + WS_CKV_W + (size_t)4 * MiB), 0, nullptr, scr, gw, ngw, lane);
        convert_matrix(args.in[9], DM, DIL_N, (bf16_t*)(ws + WS_DIL_IN), 0, args.in[5] + DM, scr, gw, ngw, lane);
        convert_matrix(args.in[4] + (size_t)DFF * DM, DFF, DM, (bf16_t*)(ws + WS_FFN_OUT + (size_t)2 * SZ_FFN_OUT), 0, nullptr, scr, gw, ngw, lane);
        convert_matrix(args.in[3] + (size_t)DM * 2 * DFF, DM, 2 * DFF, (bf16_t*)(ws + WS_FFN_IN + (size_t)2 * SZ_FFN_IN), 1, args.in[2] + DM, scr, gw, ngw, lane);
        convert_matrix(args.in[19], DFF, DM, (bf16_t*)(ws + WS_FFN_OUT + (size_t)1 * SZ_FFN_OUT), 0, nullptr, scr, gw, ngw, lane);
        convert_matrix(args.in[18], DM, 2 * DFF, (bf16_t*)(ws + WS_FFN_IN + (size_t)1 * SZ_FFN_IN), 1, args.in[17], scr, gw, ngw, lane);
        convert_matrix(args.in[16], CR_HD, DM, (bf16_t*)(ws + WS_CO_W), 0, nullptr, scr, gw, ngw, lane);
        convert_matrix(args.in[15], DM, CR_KV, (bf16_t*)(ws + WS_CKV_W), 0, nullptr, scr, gw, ngw, lane);
        convert_matrix(args.in[14], DM, CR_HD, (bf16_t*)(ws + WS_CQ_W), 0, args.in[12], scr, gw, ngw, lane);
        convert_matrix(args.in[8], DM, DM, (bf16_t*)(ws + WS_FOX_OUT), 0, nullptr, scr, gw, ngw, lane);
        convert_matrix(args.in[6], DM, FOX_N, (bf16_t*)(ws + WS_FOX_IN), 0, args.in[5], scr, gw, ngw, lane);
        convert_matrix(args.in[4], DFF, DM, (bf16_t*)(ws + WS_FFN_OUT), 0, nullptr, scr, gw, ngw, lane);
        convert_matrix(args.in[3], DM, 2 * DFF, (bf16_t*)(ws + WS_FFN_IN), 1, args.in[2], scr, gw, ngw, lane);
        rms_rows_bf16(args.in[1], args.in[13], MEMN, DM, TMEM, gw, ngw, lane);
        rows_to_xb(args.in[0], XB, PP, TOK, gw, ngw, lane);
    }
    grid.sync(); }
    Topo T;
    T.fast = (G == 256);
    if (T.fast) {
        const int xcd = bx & 7, kk = bx >> 3;
        T.b0 = xcd; T.NB = 1; T.nloc = 32; T.k = kk; T.pm = 8 * xcd + (kk & 7); T.member = kk >> 3;
        T.xcnt = ctl + 64 * xcd; T.pcnt = ctl + 64 * (8 + T.pm); T.nx = 32u; T.np = 4u;
        const unsigned mine = __hip_atomic_load(ctl + 8192 + bx, __ATOMIC_RELAXED, __HIP_MEMORY_SCOPE_AGENT); int same = 1;
        for (int j = 0; j < 32; ++j) same &= (__hip_atomic_load(ctl + 8192 + xcd + 8 * j, __ATOMIC_RELAXED, __HIP_MEMORY_SCOPE_AGENT) == mine) ? 1 : 0;
        T.wb = __builtin_amdgcn_readfirstlane(same) ? 0 : 1;
    } else {
        T.b0 = 0; T.NB = 8; T.nloc = G; T.k = bx; T.pm = 0; T.member = 0;
        T.xcnt = ctl + 64 * 100; T.pcnt = T.xcnt; T.nx = (unsigned)G; T.np = (unsigned)G; T.wb = 1;
    }
    if (T.fast) { for (int d_ = (bx & 7) * 2; d_ > 0; --d_) __builtin_amdgcn_s_sleep(127); }
    ffn_phases<0, 0>(PH_ARGS);
    mixer_phases<0>(PH_ARGS);
    ffn_phases<0, 1>(PH_ARGS);
    ffn_phases<1, 0>(PH_ARGS);
    mixer_phases<1>(PH_ARGS);
    ffn_phases<1, 1>(PH_ARGS);
    PHASE_BEGIN
    if (T.fast) rms_rows_f32_inplace(xr + (size_t)(256 * T.pm + 64 * T.member) * DM, args.in[20], 64, wave, 8, lane);
    else rms_rows_f32_inplace(xr, args.in[20], TOK, gw, ngw, lane);
    PHASE_END_LAST
}

extern "C" void kernel_launch(void* const* d_in, const int* in_sizes, int n_in, void* d_out, int out_size, void* d_ws, size_t ws_size, hipStream_t stream) {
    static int grid = 0;
    if (grid == 0) {
        if (n_in != 21 || out_size != TOK * DM || ws_size < WS_END) { fprintf(stderr, "kernel_launch: unexpected problem (n_in %d out %d ws %zu need %zu)\n", n_in, out_size, ws_size, (size_t)WS_END); grid = -1; return; }
        int dev = 0, cus = 0, per_cu = 0;
        if (hipGetDevice(&dev) != hipSuccess || hipDeviceGetAttribute(&cus, hipDeviceAttributeMultiprocessorCount, dev) != hipSuccess) { grid = -1; return; }
        if (hipFuncSetAttribute((const void*)fwd_megakernel, hipFuncAttributeMaxDynamicSharedMemorySize, LDS_BYTES) != hipSuccess) { fprintf(stderr, "kernel_launch: hipFuncSetAttribute failed\n"); grid = -1; return; }
        if (hipOccupancyMaxActiveBlocksPerMultiprocessor(&per_cu, (const void*)fwd_megakernel, 512, LDS_BYTES) != hipSuccess || per_cu < 1) { fprintf(stderr, "kernel_launch: occupancy query says %d\n", per_cu); per_cu = 1; }
        (void)hipGetLastError();
        grid = cus * per_cu;
    }
    if (grid < 0) return;
    KArgs a{};
    for (int i = 0; i < 21; ++i) a.in[i] = (const float*)d_in[i];
    a.out = (float*)d_out; a.ws = (unsigned char*)d_ws;
    void* kargs[] = {&a};
    hipError_t e = hipLaunchCooperativeKernel((const void*)fwd_megakernel, dim3(grid), dim3(512), kargs, LDS_BYTES, stream);
    if (e != hipSuccess) fprintf(stderr, "kernel_launch: cooperative launch failed: %s (grid %d)\n", hipGetErrorString(e), grid);
}
```
